# Optimizing an MI355X kernel written in HIP

```python
import math
import jax, jax.numpy as jnp
from jax import lax
import numpy as np

D_MODEL = 2048
BATCH = 2
SEQ = 4096
DEPTH = 1

HEAD_DIM = 128
ATTN_WIDTH = D_MODEL // 2
N_ATTN_HEADS = ATTN_WIDTH // HEAD_DIM
CONV_WIDTH = D_MODEL - ATTN_WIDTH
CONV_K = 3
IN_WIDTH = 3 * ATTN_WIDTH + 3 * CONV_WIDTH
D_FF = ((8 * D_MODEL // 3 + 255) // 256) * 256
N_MOD = 9
Q_BLOCK = 128
FFN_RES = 0.5
EPS = 1e-6

kernel_name = "hymba_stickbreak_shortconv_macaron_adaln"


def rms_norm(h):
    hf = h.astype(jnp.float32)
    hf = hf * lax.rsqrt(jnp.mean(hf * hf, axis=-1, keepdims=True) + EPS)
    return hf.astype(h.dtype)


def rms_norm_gain(h, gain):
    return rms_norm(h) * gain


def modulate(h, shift, scale):
    return h * (1.0 + scale[:, None, :]) + shift[:, None, :]


def swiglu(h, w_gu, w_down):
    gate, up = jnp.split(h @ w_gu, 2, axis=-1)
    return (jax.nn.silu(gate) * up) @ w_down


def stick_breaking_attention(q, k, v):
    seq = q.shape[2]
    inv_sqrt_d = 1.0 / math.sqrt(q.shape[-1])
    qf = q.astype(jnp.float32)
    kf = k.astype(jnp.float32)
    outs = []
    for b in range(seq // Q_BLOCK):
        t0, t1 = b * Q_BLOCK, (b + 1) * Q_BLOCK
        z = jnp.einsum('bhtd,bhsd->bhts', qf[:, :, t0:t1], kf[:, :, :t1]) * inv_sqrt_d
        t_idx = t0 + jnp.arange(Q_BLOCK)[:, None]
        s_idx = jnp.arange(t1)[None, :]
        causal = s_idx < t_idx
        log_fail = jnp.where(causal, jax.nn.log_sigmoid(-z), 0.0)
        log_tail = lax.cumsum(log_fail, axis=3, reverse=True) - log_fail
        a = jnp.where(causal, jnp.exp(jax.nn.log_sigmoid(z) + log_tail), 0.0)
        outs.append(jnp.einsum('bhts,bhsd->bhtd', a.astype(v.dtype), v[:, :, :t1]))
    return jnp.concatenate(outs, axis=2)


def causal_short_conv(u, w):
    ch = u.shape[-1]
    return lax.conv_general_dilated(
        u, w[:, None, :], window_strides=(1,), padding=[(CONV_K - 1, 0)],
        dimension_numbers=('NWC', 'WIO', 'NWC'), feature_group_count=ch)


def hybrid_mixer(h, w_in, q_norm_w, k_norm_w, conv_w, w_out):
    bsz, seq, _ = h.shape
    proj = h @ w_in
    offs = np.cumsum([ATTN_WIDTH, ATTN_WIDTH, ATTN_WIDTH, CONV_WIDTH, CONV_WIDTH])
    q, k, v, gate_b, gate_c, u = jnp.split(proj, list(offs), axis=-1)
    def heads(t):
        return t.reshape(bsz, seq, N_ATTN_HEADS, HEAD_DIM)
    q = rms_norm_gain(heads(q), q_norm_w).transpose(0, 2, 1, 3)
    k = rms_norm_gain(heads(k), k_norm_w).transpose(0, 2, 1, 3)
    v = heads(v).transpose(0, 2, 1, 3)
    attn = stick_breaking_attention(q, k, v).transpose(0, 2, 1, 3).reshape(bsz, seq, ATTN_WIDTH)
    conv = gate_b * causal_short_conv(gate_c * u, conv_w)
    return jnp.concatenate([attn, conv], axis=-1) @ w_out


def setup_inputs(seed: int = 0) -> dict:
    key = jax.random.key(seed)
    ks = jax.random.split(key, 13)
    f32 = jnp.float32
    def nrm(k, shape, scale):
        return jax.random.normal(k, shape, f32) * scale
    return {
        "x": nrm(ks[0], (BATCH, SEQ, D_MODEL), 1.0),
        "c": nrm(ks[1], (BATCH, D_MODEL), 1.0),
        "w_ada": nrm(ks[2], (DEPTH, D_MODEL, N_MOD * D_MODEL), 0.5 * D_MODEL ** -0.5),
        "b_ada": nrm(ks[3], (DEPTH, N_MOD * D_MODEL), 0.02),
        "w1_gu": nrm(ks[4], (DEPTH, D_MODEL, 2 * D_FF), D_MODEL ** -0.5),
        "w1_down": nrm(ks[5], (DEPTH, D_FF, D_MODEL), D_FF ** -0.5),
        "w_in": nrm(ks[6], (DEPTH, D_MODEL, IN_WIDTH), D_MODEL ** -0.5),
        "q_norm_w": 1.0 + nrm(ks[7], (DEPTH, HEAD_DIM), 0.02),
        "k_norm_w": 1.0 + nrm(ks[8], (DEPTH, HEAD_DIM), 0.02),
        "conv_w": nrm(ks[9], (DEPTH, CONV_K, CONV_WIDTH), CONV_K ** -0.5),
        "w_out": nrm(ks[10], (DEPTH, D_MODEL, D_MODEL), D_MODEL ** -0.5),
        "w2_gu": nrm(ks[11], (DEPTH, D_MODEL, 2 * D_FF), D_MODEL ** -0.5),
        "w2_down": nrm(ks[12], (DEPTH, D_FF, D_MODEL), D_FF ** -0.5),
    }


def reference(x, c, w_ada, b_ada, w1_gu, w1_down, w_in, q_norm_w, k_norm_w,
              conv_w, w_out, w2_gu, w2_down):
    c_act = jax.nn.silu(c)
    for l in range(DEPTH):
        mod = c_act @ w_ada[l] + b_ada[l]
        (sh1, sc1, g1, sh2, sc2, g2, sh3, sc3, g3) = jnp.split(mod, N_MOD, axis=-1)
        h = modulate(rms_norm(x), sh1, sc1)
        x = x + FFN_RES * g1[:, None, :] * swiglu(h, w1_gu[l], w1_down[l])
        h = modulate(rms_norm(x), sh2, sc2)
        x = x + g2[:, None, :] * hybrid_mixer(h, w_in[l], q_norm_w[l], k_norm_w[l], conv_w[l], w_out[l])
        h = modulate(rms_norm(x), sh3, sc3)
        x = x + FFN_RES * g3[:, None, :] * swiglu(h, w2_gu[l], w2_down[l])
    return x
```

```cpp
#include <hip/hip_runtime.h>
#include <hip/hip_cooperative_groups.h>
#include <cstdio>
#include <cstdint>
namespace cg = cooperative_groups;
#ifndef MK_COOP
#define MK_COOP 1
#endif
namespace pg8 {
#define PG8_LAS __attribute__((address_space(3)))
typedef unsigned short bf16_t;
typedef short bf16x8 __attribute__((ext_vector_type(8)));
typedef float f32x4 __attribute__((ext_vector_type(4)));
typedef unsigned u32x4 __attribute__((ext_vector_type(4)));
constexpr int BM = 256, BK = 64, HALF = 128, HTB = HALF * BK * 2  , STAGE_BYTES = 8 * HTB, NXCD = 8, WGM = 8;

__host__ __device__ __forceinline__ int lds_byte(int r, int c) { const int st = (r >> 4) * 2 + (c >> 5), rr = r & 15, cc = c & 31, ob = rr * 64 + cc * 2; return st * 1024 + (ob ^ (((ob >> 9) & 1) << 5)); }
__host__ __device__ __forceinline__ void stage_rc(int b, int& R, int& C) { const int st = b / 1024, sb = b % 1024, swz = sb ^ (((sb >> 9) & 1) << 5); R = (st >> 1) * 16 + swz / 64; C = (st & 1) * 32 + (swz % 64) / 2; }
__host__ __device__ __forceinline__ int perm32(int rho) { const int n = rho >> 4, i = rho & 15; return 8 * (i >> 2) + 4 * n + (i & 3); }

struct Unit { int pm, pn; };
struct Gemm { const bf16_t* A; const bf16_t* Bt; int M, N, K; };

struct StaticOrder {
    int nM, nN, nwg, G, c;
    __host__ __device__ void init(int M, int N, int G_, int c_) { nM = M / BM; nN = N / BM; nwg = nM * nN; G = G_; c = c_; }
    __host__ __device__ bool next(int i, Unit& u) const {
        const long L = (long)i * G + c; if (L >= nwg) return false;
        int wgid = (int)L; { const int q = nwg / NXCD, r = nwg % NXCD, xcd = wgid % NXCD, off = wgid / NXCD; wgid = (xcd < r ? xcd * (q + 1) : r * (q + 1) + (xcd - r) * q) + off; }
        const int nig = WGM * nN, gid = wgid / nig, fm = gid * WGM, gsz = (nM - fm) < WGM ? (nM - fm) : WGM;
        u.pm = fm + ((wgid % nig) % gsz); u.pn = (wgid % nig) / gsz; return true;
    }
    __device__ __forceinline__ void a_ready(const Unit&) const {}
    __device__ __forceinline__ void done(const Unit&) const {}
};

__device__ __forceinline__ unsigned cvt_pk_bf16(float lo, float hi) { unsigned r; asm volatile("v_cvt_pk_bf16_f32 %0, %1, %2" : "=v"(r) : "v"(lo), "v"(hi)); return r; }
typedef float f32x2 __attribute__((ext_vector_type(2)));
template <class Epi, class Sched, bool ALIGN_EPI = false, bool SP2 = false>
__device__ __forceinline__ void gemm_phase(PG8_LAS unsigned char* lds, const Gemm g, const Sched& S, const Epi& E) {
    const int tid = threadIdx.x, wid = __builtin_amdgcn_readfirstlane(tid >> 6), lane = tid & 63, wr = wid >> 2, wc = wid & 3, fr = lane & 15, fq = lane >> 4;
    const int K = g.K, nt = K / BK;
    unsigned voffA[2], voffB[2];
#pragma unroll
    for (int i = 0; i < 2; ++i) { int R, C; stage_rc(tid * 16 + i * 8192, R, C); const int Rb = Epi::PERM ? ((R & ~31) + perm32(R & 31)) : R;
        voffA[i] = (unsigned)(R * K + C) * 2u; voffB[i] = (unsigned)(Rb * K + C) * 2u; }
    const size_t kstep = (size_t)(BK * 2);
    const size_t hstep = (size_t)HALF * K * 2;
    const size_t tstep = 2 * hstep;
    const unsigned ldsw = (unsigned)wid * 1024u;
    const int aoff = lds_byte(wr * 64 + fr, fq * 8), boff = lds_byte(wc * 32 + fr, fq * 8);
#define PG8_SA(b, h) (((b) * 2 + (h)) * HTB)
#define PG8_SB(b, h) ((4 + (b) * 2 + (h)) * HTB)
#define PG8_STAGE(bufoff, gbase, voff) do { _Pragma("unroll") for (int _i = 0; _i < 2; ++_i) \
        __builtin_amdgcn_global_load_lds((const unsigned*)((const char*)(gbase) + (voff)[_i]), (PG8_LAS unsigned*)(lds + (bufoff) + ldsw + _i * 8192), 16, 0, 0); } while (0)
#define PG8_LDA(dst, b, h) do { _Pragma("unroll") for (int m = 0; m < 4; ++m) _Pragma("unroll") for (int k = 0; k < 2; ++k) dst[m][k] = *(const PG8_LAS bf16x8*)(lds + PG8_SA(b, h) + aoff + m * 2048 + k * 1024); } while (0)
#define PG8_LDB(dst, b, h) do { _Pragma("unroll") for (int n = 0; n < 2; ++n) _Pragma("unroll") for (int k = 0; k < 2; ++k) dst[n][k] = *(const PG8_LAS bf16x8*)(lds + PG8_SB(b, h) + boff + n * 2048 + k * 1024); } while (0)
#define PG8_MMA(ai, bj, At, Bt) do { __builtin_amdgcn_s_setprio(1); _Pragma("unroll") for (int m = 0; m < 4; ++m) _Pragma("unroll") for (int n = 0; n < 2; ++n) _Pragma("unroll") for (int k = 0; k < 2; ++k) \
        acc[ai][bj][m][n] = __builtin_amdgcn_mfma_f32_16x16x32_bf16(Bt[n][k], At[m][k], acc[ai][bj][m][n], 0, 0, 0); __builtin_amdgcn_s_setprio(0); } while (0)
#define PG8_WAIT_V(n) asm volatile("s_waitcnt vmcnt(" #n ")" ::: "memory")
#define PG8_WAIT_L(n) asm volatile("s_waitcnt lgkmcnt(" #n ")" ::: "memory")
#define PG8_BAR __builtin_amdgcn_s_barrier()
#define PG8_SCHED __builtin_amdgcn_sched_barrier(0)
    Unit cur, nxt; int ui = 0;
    if (!S.next(0, cur)) return;
    f32x4 acc[2][2][4][2];
#pragma unroll
    for (int a = 0; a < 2; ++a)
#pragma unroll
        for (int b = 0; b < 2; ++b)
#pragma unroll
            for (int m = 0; m < 4; ++m)
#pragma unroll
                for (int n = 0; n < 2; ++n) acc[a][b][m][n] = (f32x4){0.f, 0.f, 0.f, 0.f};
    bf16x8 At[4][2], B0[2][2], B1[2][2];
    const char* cA = (const char*)g.A + (size_t)cur.pm * tstep; const char* cB = (const char*)g.Bt + (size_t)cur.pn * tstep;
    S.a_ready(cur);
    if constexpr (SP2) {
        PG8_STAGE(PG8_SB(0, 0), cB, voffB); PG8_STAGE(PG8_SB(0, 1), cB + hstep, voffB); PG8_STAGE(PG8_SA(0, 0), cA, voffA); PG8_STAGE(PG8_SA(0, 1), cA + hstep, voffA);
        if (wr == 1) PG8_BAR;
        PG8_WAIT_V(2); PG8_BAR;
        PG8_STAGE(PG8_SB(1, 0), cB + kstep, voffB); PG8_STAGE(PG8_SA(1, 0), cA + kstep, voffA); PG8_STAGE(PG8_SB(1, 1), cB + hstep + kstep, voffB);
        PG8_WAIT_V(6); PG8_BAR;
    } else {
        PG8_STAGE(PG8_SB(0, 0), cB, voffB); PG8_STAGE(PG8_SA(0, 0), cA, voffA); PG8_STAGE(PG8_SB(0, 1), cB + hstep, voffB); PG8_STAGE(PG8_SA(0, 1), cA + hstep, voffA);
        if (wr == 1) PG8_BAR;
        PG8_WAIT_V(4); PG8_BAR;
        PG8_STAGE(PG8_SB(1, 0), cB + kstep, voffB); PG8_STAGE(PG8_SA(1, 0), cA + kstep, voffA); PG8_STAGE(PG8_SB(1, 1), cB + hstep + kstep, voffB);
        PG8_WAIT_V(6); PG8_BAR;
    }
    for (;;) {
        const bool has_next = S.next(ui + 1, nxt);
        const char* nA = has_next ? (const char*)g.A + (size_t)nxt.pm * tstep : cA; const char* nB = has_next ? (const char*)g.Bt + (size_t)nxt.pn * tstep : cB;
        for (int t = 0; t < nt; t += 2) {
            const bool last = (t == nt - 2);
            const char* a1 = cA + (size_t)(t + 1) * kstep;
            const char* a2 = last ? nA : cA + (size_t)(t + 2) * kstep; const char* b2 = last ? nB : cB + (size_t)(t + 2) * kstep;
            const char* a3 = a2 + kstep; const char* b3 = b2 + kstep;
            if (last && has_next) S.a_ready(nxt);
            if constexpr (SP2) {
            PG8_LDB(B0, 0, 0); PG8_LDB(B1, 0, 1); PG8_SCHED; PG8_LDA(At, 0, 0); PG8_STAGE(PG8_SA(1, 1), a1 + hstep, voffA);
            PG8_WAIT_V(8); PG8_WAIT_L(0); PG8_BAR; PG8_MMA(0, 0, At, B0); PG8_MMA(0, 1, At, B1); PG8_BAR; PG8_SCHED;
            PG8_LDA(At, 0, 1); PG8_STAGE(PG8_SB(0, 0), b2, voffB); PG8_STAGE(PG8_SB(0, 1), b2 + hstep, voffB); PG8_STAGE(PG8_SA(0, 0), a2, voffA);
            PG8_WAIT_V(8); PG8_WAIT_L(0); PG8_BAR; PG8_MMA(1, 0, At, B0); PG8_MMA(1, 1, At, B1); PG8_BAR; PG8_SCHED;
            PG8_LDB(B0, 1, 0); PG8_LDB(B1, 1, 1); PG8_SCHED; PG8_LDA(At, 1, 0); PG8_STAGE(PG8_SA(0, 1), a2 + hstep, voffA);
            PG8_WAIT_V(8); PG8_WAIT_L(0); PG8_BAR; PG8_MMA(0, 0, At, B0); PG8_MMA(0, 1, At, B1); PG8_BAR; PG8_SCHED;
            PG8_LDA(At, 1, 1); PG8_STAGE(PG8_SB(1, 0), b3, voffB); PG8_STAGE(PG8_SB(1, 1), b3 + hstep, voffB); PG8_STAGE(PG8_SA(1, 0), a3, voffA);
            PG8_WAIT_V(8); PG8_WAIT_L(0); PG8_BAR; PG8_MMA(1, 0, At, B0); PG8_MMA(1, 1, At, B1); PG8_BAR; PG8_SCHED;
            } else {
            PG8_LDB(B0, 0, 0); PG8_SCHED; PG8_LDA(At, 0, 0); PG8_STAGE(PG8_SA(1, 1), a1 + hstep, voffA);
            PG8_WAIT_L(8); PG8_BAR; PG8_WAIT_L(0); PG8_MMA(0, 0, At, B0); PG8_BAR; PG8_SCHED;
            PG8_LDB(B1, 0, 1); PG8_STAGE(PG8_SB(0, 0), b2, voffB);
            PG8_BAR; PG8_WAIT_L(0); PG8_MMA(0, 1, At, B1); PG8_BAR;
            PG8_LDA(At, 0, 1); PG8_STAGE(PG8_SA(0, 0), a2, voffA);
            PG8_BAR; PG8_WAIT_L(0); PG8_MMA(1, 0, At, B0); PG8_BAR; PG8_SCHED;
            PG8_STAGE(PG8_SB(0, 1), b2 + hstep, voffB);
            PG8_WAIT_V(6); PG8_BAR; PG8_MMA(1, 1, At, B1); PG8_BAR;
            PG8_LDB(B0, 1, 0); PG8_SCHED; PG8_LDA(At, 1, 0); PG8_STAGE(PG8_SA(0, 1), a2 + hstep, voffA);
            PG8_WAIT_L(8); PG8_BAR; PG8_WAIT_L(0); PG8_MMA(0, 0, At, B0); PG8_BAR; PG8_SCHED;
            PG8_LDB(B1, 1, 1); PG8_STAGE(PG8_SB(1, 0), b3, voffB);
            PG8_BAR; PG8_WAIT_L(0); PG8_MMA(0, 1, At, B1); PG8_BAR;
            PG8_LDA(At, 1, 1); PG8_STAGE(PG8_SA(1, 0), a3, voffA);
            PG8_BAR; PG8_WAIT_L(0); PG8_MMA(1, 0, At, B0); PG8_BAR; PG8_SCHED;
            PG8_STAGE(PG8_SB(1, 1), b3 + hstep, voffB);
            PG8_WAIT_V(6); PG8_BAR; PG8_MMA(1, 1, At, B1); PG8_BAR;
            }
        }
        if constexpr (ALIGN_EPI) { if (wr == 0) PG8_BAR; }
        if constexpr (!Epi::AFTER_DRAIN) { E(acc, cur, wr, wc, fr, fq); S.done(cur); }
        if (!has_next) break;
#pragma unroll
        for (int a = 0; a < 2; ++a)
#pragma unroll
            for (int b = 0; b < 2; ++b)
#pragma unroll
                for (int m = 0; m < 4; ++m)
#pragma unroll
                    for (int n = 0; n < 2; ++n) acc[a][b][m][n] = (f32x4){0.f, 0.f, 0.f, 0.f};
        cur = nxt; cA = nA; cB = nB; ++ui;
        if constexpr (ALIGN_EPI) { if (wr == 1) PG8_BAR; }
    }
    PG8_WAIT_V(0);
    if constexpr (!ALIGN_EPI) { if (wr == 0) PG8_BAR; }
    PG8_BAR;
    if constexpr (Epi::AFTER_DRAIN) { E.fused(acc, cur, wr, wc, fr, fq, lds, wid, lane); S.done(cur); }
#undef PG8_SA
#undef PG8_SB
#undef PG8_STAGE
#undef PG8_LDA
#undef PG8_LDB
#undef PG8_MMA
#undef PG8_WAIT_V
#undef PG8_WAIT_L
#undef PG8_BAR
#undef PG8_SCHED
}
}

constexpr int BATCH = 2, SEQ = 4096, D = 2048, M = BATCH * SEQ, FF = 5632, NIN = 6144, NHEAD = 8, HD = 128, NMOD = 9;
constexpr int NWAVES = 8;
constexpr float EPS = 1e-6f;
constexpr float LOG2E = 1.4426950408889634f;
constexpr float QSCALE = 0.08838834764831845f * LOG2E;
constexpr size_t MiB = 1u << 20;
constexpr size_t WS_MOD = 0, MOD_BYTES = (size_t)BATCH * NMOD * D * 4;
constexpr size_t WS_W1GU = 1 * MiB, WS_W1D = 45 * MiB, WS_WIN = 67 * MiB, WS_WOUT = 91 * MiB, WS_W2GU = 99 * MiB, WS_W2D = 143 * MiB;
constexpr size_t WS_H = 165 * MiB, WS_BIG = 197 * MiB, WS_X1 = 293 * MiB, WS_AI = 357 * MiB, WS_QN = 389 * MiB, WS_KN = 405 * MiB, WS_VT = 421 * MiB, WS_END = 437 * MiB;
constexpr int LDS_BYTES = 147456;
constexpr int N_PHASES = 12;

#define LAS __attribute__((address_space(3)))
typedef unsigned short bf16_t;
typedef float f32x4 __attribute__((ext_vector_type(4)));
typedef float f32x16 __attribute__((ext_vector_type(16)));
typedef unsigned u32x4 __attribute__((ext_vector_type(4)));
typedef short bf16x8 __attribute__((ext_vector_type(8)));
typedef float f32x2_t __attribute__((ext_vector_type(2)));
typedef __bf16 bf16x2_t __attribute__((ext_vector_type(2)));
#define LDS_WAIT() asm volatile("s_waitcnt lgkmcnt(0)" ::: "memory")
__device__ __forceinline__ unsigned pk2(float lo, float hi) { f32x2_t v = {lo, hi}; bf16x2_t b = __builtin_convertvector(v, bf16x2_t); return __builtin_bit_cast(unsigned, b); }
__device__ __forceinline__ float bflo(unsigned u) { return __uint_as_float(u << 16); }
__device__ __forceinline__ float bfhi(unsigned u) { return __uint_as_float(u & 0xffff0000u); }
__device__ __forceinline__ float wave_sum(float v) {
#pragma unroll
    for (int o = 1; o < 64; o <<= 1) v += __shfl_xor(v, o);
    return v;
}
__device__ __forceinline__ float silu_f(float v) { return v * __builtin_amdgcn_rcpf(1.0f + __builtin_amdgcn_exp2f(-v * LOG2E)); }

namespace pg8 {
struct EpiStore {
    static constexpr bool PERM = true, AFTER_DRAIN = false;
    bf16_t* O; int ldc;
    __device__ __forceinline__ void operator()(const f32x4 (&acc)[2][2][4][2], const Unit& u, int wr, int wc, int fr, int fq) const {
        const int row0 = u.pm * BM + wr * 64 + fr, col0 = u.pn * BM + wc * 32 + 8 * fq;
#pragma unroll
        for (int ai = 0; ai < 2; ++ai)
#pragma unroll
            for (int m = 0; m < 4; ++m) { bf16_t* rowp = O + (size_t)(row0 + ai * HALF + m * 16) * ldc + col0;
#pragma unroll
                for (int bj = 0; bj < 2; ++bj) { const f32x4 v0 = acc[ai][bj][m][0], v1 = acc[ai][bj][m][1];
                    u32x4 w; w.x = ::pk2(v0[0], v0[1]); w.y = ::pk2(v0[2], v0[3]); w.z = ::pk2(v1[0], v1[1]); w.w = ::pk2(v1[2], v1[3]);
                    *(u32x4*)(rowp + bj * HALF) = w; } }
    }
};
struct EpiSwiglu {
    static constexpr bool PERM = true, AFTER_DRAIN = false;
    bf16_t* O; int ldc;
    __device__ __forceinline__ void operator()(const f32x4 (&acc)[2][2][4][2], const Unit& u, int wr, int wc, int fr, int fq) const {
        const int row0 = u.pm * BM + wr * 64 + fr, col0 = u.pn * HALF + wc * 32 + 8 * fq;
#pragma unroll
        for (int ai = 0; ai < 2; ++ai)
#pragma unroll
            for (int m = 0; m < 4; ++m) { bf16_t* rowp = O + (size_t)(row0 + ai * HALF + m * 16) * ldc + col0;
                float r[8];
#pragma unroll
                for (int n = 0; n < 2; ++n)
#pragma unroll
                    for (int e = 0; e < 4; ++e) { const float g = acc[ai][0][m][n][e], up = acc[ai][1][m][n][e]; r[4 * n + e] = ::silu_f(g) * up; }
                u32x4 w; w.x = ::pk2(r[0], r[1]); w.y = ::pk2(r[2], r[3]); w.z = ::pk2(r[4], r[5]); w.w = ::pk2(r[6], r[7]);
                *(u32x4*)rowp = w; }
    }
};
struct EpiResid {
    static constexpr bool PERM = false, AFTER_DRAIN = false;
    const float* base; float* out; const float* gate; float scale;
    __device__ __forceinline__ void operator()(const f32x4 (&acc)[2][2][4][2], const Unit& u, int wr, int wc, int fr, int fq) const {
        const int row0 = u.pm * BM + wr * 64 + fr, col0 = u.pn * BM + wc * 32 + 4 * fq;
        const float* gp = gate + (size_t)((u.pm * BM) / SEQ) * (NMOD * D) + col0;
        f32x4 gv[2][2];
#pragma unroll
        for (int bj = 0; bj < 2; ++bj)
#pragma unroll
            for (int n = 0; n < 2; ++n) gv[bj][n] = *(const f32x4*)(gp + bj * HALF + n * 16) * scale;
#pragma unroll
        for (int ai = 0; ai < 2; ++ai)
#pragma unroll
            for (int m = 0; m < 4; ++m) { const size_t off = (size_t)(row0 + ai * HALF + m * 16) * D + col0;
#pragma unroll
                for (int bj = 0; bj < 2; ++bj)
#pragma unroll
                    for (int n = 0; n < 2; ++n) { const f32x4 bs = *(const f32x4*)(base + off + bj * HALF + n * 16);
                        *(f32x4*)(out + off + bj * HALF + n * 16) = bs + gv[bj][n] * acc[ai][bj][m][n]; } }
    }
};
}

struct Ctx {
    LAS unsigned char* lds; int tid, lane, wave, gw, NGW;
};

__device__ __forceinline__ void tr_item_f32(const float* __restrict__ src, int N, int k0, int n0, bf16_t* __restrict__ dst, size_t dpitch, size_t drow0, LAS unsigned* T, int lane) {
    const int nq = lane & 15, kr = lane >> 4;
    const float* s = src + (size_t)(k0 + 2 * kr) * N + n0 + 4 * nq;
    f32x4 a[8], b[8];
#pragma unroll
    for (int it = 0; it < 8; ++it) { a[it] = __builtin_nontemporal_load((const f32x4*)(s + (size_t)(8 * it) * N)); b[it] = __builtin_nontemporal_load((const f32x4*)(s + (size_t)(8 * it + 1) * N)); }
#pragma unroll
    for (int it = 0; it < 8; ++it) { const int kp = it * 4 + kr;
#pragma unroll
        for (int j = 0; j < 4; ++j) T[(4 * nq + j) * 33 + kp] = pk2(a[it][j], b[it][j]); }
    LDS_WAIT();
    const int c = lane & 7, nn = lane >> 3;
#pragma unroll
    for (int jj = 0; jj < 8; ++jj) { const int n = nn + 8 * jj; const LAS unsigned* p = T + n * 33 + 4 * c;
        u32x4 o; o.x = p[0]; o.y = p[1]; o.z = p[2]; o.w = p[3];
        *(u32x4*)(dst + (drow0 + n) * dpitch + k0 + 8 * c) = o; }
    LDS_WAIT();
}
__device__ __forceinline__ void tr_item_bf16(const bf16_t* __restrict__ src, size_t spitch, bf16_t* __restrict__ dst, size_t dpitch, LAS unsigned* T, int lane) {
    const int dq = lane & 7, kr = lane >> 3;
    const bf16_t* s = src + (size_t)(2 * kr) * spitch + 8 * dq;
    u32x4 a[4], b[4];
#pragma unroll
    for (int it = 0; it < 4; ++it) { a[it] = *(const u32x4*)(s + (size_t)(16 * it) * spitch); b[it] = *(const u32x4*)(s + (size_t)(16 * it + 1) * spitch); }
#pragma unroll
    for (int it = 0; it < 4; ++it) { const int kp = it * 8 + kr;
#pragma unroll
        for (int j = 0; j < 4; ++j) { const unsigned x = a[it][j], y = b[it][j];
            T[(8 * dq + 2 * j) * 33 + kp] = (x & 0xffffu) | (y << 16);
            T[(8 * dq + 2 * j + 1) * 33 + kp] = (x >> 16) | (y & 0xffff0000u); } }
    LDS_WAIT();
    const int c = lane & 7, nn = lane >> 3;
#pragma unroll
    for (int jj = 0; jj < 8; ++jj) { const int n = nn + 8 * jj; const LAS unsigned* p = T + n * 33 + 4 * c;
        u32x4 o; o.x = p[0]; o.y = p[1]; o.z = p[2]; o.w = p[3];
        *(u32x4*)(dst + (size_t)n * dpitch + 8 * c) = o; }
    LDS_WAIT();
}

__device__ __forceinline__ void tr_weight_item(const float* W, int K, int N, bf16_t* WT, bool gu, int item, LAS unsigned* T, int lane) {
    const int nblk = N / 64, kb = item / nblk, nb = item % nblk, n0 = nb * 64;
    size_t drow0 = n0;
    if (gu) { const int half = (n0 >= FF) ? 1 : 0, j = n0 - half * FF; drow0 = (size_t)(j >> 7) * 256 + half * 128 + (j & 127); }
    tr_item_f32(W, N, kb * 64, n0, WT, (size_t)K, drow0, T, lane);
}

__device__ __forceinline__ void adaln_item(const float* __restrict__ c, const float* __restrict__ w_ada, const float* __restrict__ b_ada, float* mod, int item, int lane) {
    constexpr int NC = NMOD * D;
    const int cb = item % (NC / 256), kc = item / (NC / 256), k0 = kc * 32, n0 = cb * 256 + 4 * lane;
    float s0 = 0.f, s1 = 0.f;
    if (lane < 32) { s0 = silu_f(c[k0 + lane]); s1 = silu_f(c[D + k0 + lane]); }
    f32x4 a0 = {0.f, 0.f, 0.f, 0.f}, a1 = {0.f, 0.f, 0.f, 0.f};
    const float* wp = w_ada + (size_t)k0 * NC + n0;
#pragma unroll 8
    for (int kk = 0; kk < 32; ++kk) { const f32x4 w = __builtin_nontemporal_load((const f32x4*)(wp + (size_t)kk * NC)); const float c0 = __shfl(s0, kk), c1 = __shfl(s1, kk); a0 += w * c0; a1 += w * c1; }
    if (kc == 0) { const f32x4 bv = *(const f32x4*)(b_ada + n0); a0 += bv; a1 += bv; }
#pragma unroll
    for (int e = 0; e < 4; ++e) { unsafeAtomicAdd(mod + n0 + e, a0[e]); unsafeAtomicAdd(mod + NC + n0 + e, a1[e]); }
}

__device__ __forceinline__ void norm_phase(const Ctx& C, const float* __restrict__ X, const float* __restrict__ mod, int mi, bf16_t* __restrict__ H) {
    for (int m = C.gw; m < M; m += C.NGW) {
        const float* xr = X + (size_t)m * D + 8 * C.lane;
        f32x4 v[4][2]; float ss = 0.f;
#pragma unroll
        for (int j = 0; j < 4; ++j) { v[j][0] = *(const f32x4*)(xr + 512 * j); v[j][1] = *(const f32x4*)(xr + 512 * j + 4);
            ss += (v[j][0][0] * v[j][0][0] + v[j][0][1] * v[j][0][1]) + (v[j][0][2] * v[j][0][2] + v[j][0][3] * v[j][0][3]);
            ss += (v[j][1][0] * v[j][1][0] + v[j][1][1] * v[j][1][1]) + (v[j][1][2] * v[j][1][2] + v[j][1][3] * v[j][1][3]); }
        const float rstd = __builtin_amdgcn_rsqf(wave_sum(ss) * (1.0f / D) + EPS);
        const float* sh = mod + (size_t)(m / SEQ) * (NMOD * D) + (size_t)(3 * mi) * D + 8 * C.lane; const float* sc = sh + D;
        bf16_t* hr = H + (size_t)m * D + 8 * C.lane;
#pragma unroll
        for (int j = 0; j < 4; ++j) { f32x4 r0 = v[j][0] * rstd * (*(const f32x4*)(sc + 512 * j) + 1.0f) + *(const f32x4*)(sh + 512 * j);
            f32x4 r1 = v[j][1] * rstd * (*(const f32x4*)(sc + 512 * j + 4) + 1.0f) + *(const f32x4*)(sh + 512 * j + 4);
            u32x4 w; w.x = pk2(r0[0], r0[1]); w.y = pk2(r0[2], r0[3]); w.z = pk2(r1[0], r1[1]); w.w = pk2(r1[2], r1[3]);
            *(u32x4*)(hr + 512 * j) = w; }
    }
}

__device__ __forceinline__ void prepass_phase(const Ctx& C, const bf16_t* __restrict__ PROJ, const float* __restrict__ qw, const float* __restrict__ kw, const float* __restrict__ convw,
                                              bf16_t* __restrict__ Qn, bf16_t* __restrict__ Kn, bf16_t* __restrict__ Vt, bf16_t* __restrict__ AI) {
    LAS unsigned* T = (LAS unsigned*)(C.lds + C.wave * 16384);
    constexpr int I_ROW = M, I_VT = BATCH * NHEAD * (SEQ / 64) * 2, I_CONV = BATCH * (SEQ / 32) * 2;
    for (int it = C.gw; it < I_ROW + I_VT + I_CONV; it += C.NGW) {
        if (it < I_ROW) {
            const int m = it, b = m / SEQ, s = m % SEQ, lane = C.lane;
            const bf16_t* p = PROJ + (size_t)m * NIN + 32 * lane;
            u32x4 x[4]; float f[32]; float ss = 0.f;
#pragma unroll
            for (int j = 0; j < 4; ++j) x[j] = *(const u32x4*)(p + 8 * j);
#pragma unroll
            for (int j = 0; j < 4; ++j)
#pragma unroll
                for (int e = 0; e < 4; ++e) { f[8 * j + 2 * e] = bflo(x[j][e]); f[8 * j + 2 * e + 1] = bfhi(x[j][e]); }
#pragma unroll
            for (int e = 0; e < 32; ++e) ss += f[e] * f[e];
            ss += __shfl_xor(ss, 1); ss += __shfl_xor(ss, 2);
            const int head = lane >> 2, d0 = (lane & 3) * 32; const bool isq = head < 8;
            const float rs = __builtin_amdgcn_rsqf(ss * (1.0f / HD) + EPS) * (isq ? QSCALE : 1.0f);
            const float* g = (isq ? qw : kw) + d0;
            bf16_t* o = (isq ? Qn : Kn) + (((size_t)b * NHEAD + (head & 7)) * SEQ + s) * HD + d0;
#pragma unroll
            for (int j = 0; j < 4; ++j) { const f32x4 g0 = *(const f32x4*)(g + 8 * j), g1 = *(const f32x4*)(g + 8 * j + 4);
                u32x4 w; w.x = pk2(f[8 * j] * rs * g0[0], f[8 * j + 1] * rs * g0[1]); w.y = pk2(f[8 * j + 2] * rs * g0[2], f[8 * j + 3] * rs * g0[3]);
                w.z = pk2(f[8 * j + 4] * rs * g1[0], f[8 * j + 5] * rs * g1[1]); w.w = pk2(f[8 * j + 6] * rs * g1[2], f[8 * j + 7] * rs * g1[3]);
                *(u32x4*)(o + 8 * j) = w; }
        } else if (it < I_ROW + I_VT) {
            const int r = it - I_ROW, dh = r & 1, sb = (r >> 1) % (SEQ / 64), bh = (r >> 1) / (SEQ / 64), b = bh / NHEAD, hh = bh % NHEAD;
            const bf16_t* src = PROJ + ((size_t)b * SEQ + sb * 64) * NIN + 2048 + hh * HD + dh * 64;
            bf16_t* dst = Vt + ((size_t)bh * HD + dh * 64) * SEQ + sb * 64;
            tr_item_bf16(src, NIN, dst, SEQ, T, C.lane);
        } else {
            const int r = it - I_ROW - I_VT, half = r & 1, tb = (r >> 1) % (SEQ / 32), b = (r >> 1) / (SEQ / 32), t0 = tb * 32, ch = half * 512 + 8 * C.lane;
            float w0[8], w1[8], w2[8], c1[8], c2[8];
#pragma unroll
            for (int e = 0; e < 8; ++e) { w0[e] = convw[ch + e]; w1[e] = convw[1024 + ch + e]; w2[e] = convw[2048 + ch + e]; c1[e] = 0.f; c2[e] = 0.f; }
            for (int t = t0 - 2; t < t0 + 32; ++t) {
                if (t < 0) continue;
                const bf16_t* p = PROJ + ((size_t)b * SEQ + t) * NIN + ch;
                const u32x4 gb = *(const u32x4*)(p + 3072), gc = *(const u32x4*)(p + 4096), uu = *(const u32x4*)(p + 5120);
                float cu[8], y[8];
#pragma unroll
                for (int e = 0; e < 4; ++e) { cu[2 * e] = bflo(gc[e]) * bflo(uu[e]); cu[2 * e + 1] = bfhi(gc[e]) * bfhi(uu[e]); }
#pragma unroll
                for (int e = 0; e < 4; ++e) { y[2 * e] = bflo(gb[e]) * (w0[2 * e] * c2[2 * e] + w1[2 * e] * c1[2 * e] + w2[2 * e] * cu[2 * e]);
                    y[2 * e + 1] = bfhi(gb[e]) * (w0[2 * e + 1] * c2[2 * e + 1] + w1[2 * e + 1] * c1[2 * e + 1] + w2[2 * e + 1] * cu[2 * e + 1]); }
                if (t >= t0) { u32x4 w; w.x = pk2(y[0], y[1]); w.y = pk2(y[2], y[3]); w.z = pk2(y[4], y[5]); w.w = pk2(y[6], y[7]);
                    *(u32x4*)(AI + ((size_t)b * SEQ + t) * D + 1024 + ch) = w; }
#pragma unroll
                for (int e = 0; e < 8; ++e) { c2[e] = c1[e]; c1[e] = cu[e]; }
            }
        }
    }
}

#define MFMA32(a, b, c) __builtin_amdgcn_mfma_f32_32x32x16_bf16((a), (b), (c), 0, 0, 0)
constexpr int KPITCH = 272, VPITCH = 144, LDS_KT = 0, LDS_VT = 64 * KPITCH;
__device__ __forceinline__ void attn_unit(const Ctx& C, int bh, int qb, const bf16_t* __restrict__ Qn, const bf16_t* __restrict__ Kn, const bf16_t* __restrict__ Vt, bf16_t* __restrict__ AI) {
    const int lane = C.lane, r = lane & 31, h = lane >> 5, tid = C.tid;
    const int t0 = qb * 256 + C.wave * 32, t = t0 + r;
    bf16x8 qf[8];
    { const bf16_t* Qw = Qn + ((size_t)bh * SEQ + t) * HD + 8 * h;
#pragma unroll
      for (int c = 0; c < 8; ++c) qf[c] = *(const bf16x8*)(Qw + 16 * c); }
    f32x16 o[4];
#pragma unroll
    for (int db = 0; db < 4; ++db)
#pragma unroll
        for (int i = 0; i < 16; ++i) o[db][i] = 0.f;
    float R = 0.f;
    const int jlast = qb * 4 + 3, jw = t0 >> 6;
    const int ii = (r & 3) + 4 * (r >> 3), kvm = 16 * (ii >> 3) + 8 * ((r >> 2) & 1) + (ii & 7);
    const LAS unsigned char* Kl = C.lds + LDS_KT + kvm * KPITCH + h * 16;
    const LAS unsigned char* Vl = C.lds + LDS_VT + r * VPITCH + h * 16;
    const bf16_t* Kg = Kn + (size_t)bh * SEQ * HD; const bf16_t* Vg = Vt + (size_t)bh * HD * SEQ;
    u32x4 kreg[2], vreg[2];
#define ATT_PREFETCH(j) do { _Pragma("unroll") for (int i_ = 0; i_ < 2; ++i_) { const int p_ = tid + 512 * i_; \
        kreg[i_] = *(const u32x4*)(Kg + (size_t)(j) * 64 * HD + (size_t)p_ * 8); \
        vreg[i_] = *(const u32x4*)(Vg + (size_t)(p_ >> 3) * SEQ + (j) * 64 + (p_ & 7) * 8); } } while (0)
    ATT_PREFETCH(jlast);
    for (int j = jlast; j >= 0; --j) {
        __syncthreads();
#pragma unroll
        for (int i_ = 0; i_ < 2; ++i_) { const int p_ = tid + 512 * i_;
            *(LAS u32x4*)(C.lds + LDS_KT + (p_ >> 4) * KPITCH + (p_ & 15) * 16) = kreg[i_];
            *(LAS u32x4*)(C.lds + LDS_VT + (p_ >> 3) * VPITCH + (p_ & 7) * 16) = vreg[i_]; }
        __syncthreads();
        if (j > 0) ATT_PREFETCH(j - 1);
        if (j <= jw) {
            f32x16 p0, p1;
#pragma unroll
            for (int i = 0; i < 16; ++i) { p0[i] = 0.f; p1[i] = 0.f; }
#pragma unroll
            for (int c = 0; c < 8; ++c) { const bf16x8 k0 = *(const LAS bf16x8*)(Kl + c * 32), k1 = *(const LAS bf16x8*)(Kl + 32 * KPITCH + c * 32);
                p0 = MFMA32(k0, qf[c], p0); p1 = MFMA32(k1, qf[c], p1); }
            const bool diag = (j == jw);
            const int kvb = 64 * j + 8 * h;
            float lf0[16], lf1[16];
#pragma unroll
            for (int i = 0; i < 16; ++i) {
                const int kv = kvb + 16 * (i >> 3) + (i & 7);
                { const float z = p0[i]; float l = -(fmaxf(z, 0.f) + __builtin_amdgcn_logf(1.0f + __builtin_amdgcn_exp2f(-fabsf(z)))); if (diag && kv >= t) l = 0.f; lf0[i] = l; }
                { const float z = p1[i]; float l = -(fmaxf(z, 0.f) + __builtin_amdgcn_logf(1.0f + __builtin_amdgcn_exp2f(-fabsf(z)))); if (diag && kv + 32 >= t) l = 0.f; lf1[i] = l; }
            }
            float gs[4], og[4];
            gs[0] = ((lf0[0] + lf0[1]) + (lf0[2] + lf0[3])) + ((lf0[4] + lf0[5]) + (lf0[6] + lf0[7]));
            gs[1] = ((lf0[8] + lf0[9]) + (lf0[10] + lf0[11])) + ((lf0[12] + lf0[13]) + (lf0[14] + lf0[15]));
            gs[2] = ((lf1[0] + lf1[1]) + (lf1[2] + lf1[3])) + ((lf1[4] + lf1[5]) + (lf1[6] + lf1[7]));
            gs[3] = ((lf1[8] + lf1[9]) + (lf1[10] + lf1[11])) + ((lf1[12] + lf1[13]) + (lf1[14] + lf1[15]));
#pragma unroll
            for (int g = 0; g < 4; ++g) og[g] = __shfl_xor(gs[g], 32);
            float off[4]; float run = R;
#pragma unroll
            for (int g = 3; g >= 0; --g) { off[g] = run + (h == 0 ? og[g] : 0.f); run += gs[g] + og[g]; }
            R = run;
#pragma unroll
            for (int g = 0; g < 2; ++g) { float c = off[g];
#pragma unroll
                for (int e = 7; e >= 0; --e) { const int i = 8 * g + e; c += lf0[i]; const int kv = kvb + 16 * g + e; float a = __builtin_amdgcn_exp2f(p0[i] + c); if (diag && kv >= t) a = 0.f; p0[i] = a; } }
#pragma unroll
            for (int g = 0; g < 2; ++g) { float c = off[2 + g];
#pragma unroll
                for (int e = 7; e >= 0; --e) { const int i = 8 * g + e; c += lf1[i]; const int kv = kvb + 32 + 16 * g + e; float a = __builtin_amdgcn_exp2f(p1[i] + c); if (diag && kv >= t) a = 0.f; p1[i] = a; } }
            bf16x8 pa[4];
            { u32x4 w;
              w.x = pk2(p0[0], p0[1]); w.y = pk2(p0[2], p0[3]); w.z = pk2(p0[4], p0[5]); w.w = pk2(p0[6], p0[7]); pa[0] = __builtin_bit_cast(bf16x8, w);
              w.x = pk2(p0[8], p0[9]); w.y = pk2(p0[10], p0[11]); w.z = pk2(p0[12], p0[13]); w.w = pk2(p0[14], p0[15]); pa[1] = __builtin_bit_cast(bf16x8, w);
              w.x = pk2(p1[0], p1[1]); w.y = pk2(p1[2], p1[3]); w.z = pk2(p1[4], p1[5]); w.w = pk2(p1[6], p1[7]); pa[2] = __builtin_bit_cast(bf16x8, w);
              w.x = pk2(p1[8], p1[9]); w.y = pk2(p1[10], p1[11]); w.z = pk2(p1[12], p1[13]); w.w = pk2(p1[14], p1[15]); pa[3] = __builtin_bit_cast(bf16x8, w); }
#pragma unroll
            for (int db = 0; db < 4; ++db)
#pragma unroll
                for (int s = 0; s < 4; ++s) { const bf16x8 vf = *(const LAS bf16x8*)(Vl + db * 32 * VPITCH + s * 32); o[db] = MFMA32(pa[s], vf, o[db]); }
        }
    }
#undef ATT_PREFETCH
    const int b = bh / NHEAD, hh = bh % NHEAD;
#pragma unroll
    for (int i = 0; i < 16; ++i) { const int q = (i & 3) + 8 * (i >> 2) + 4 * h; bf16_t* op = AI + ((size_t)b * SEQ + t0 + q) * D + hh * HD + r;
#pragma unroll
        for (int db = 0; db < 4; ++db) op[32 * db] = (bf16_t)(pk2(o[db][i], 0.f) & 0xffffu); }
    __syncthreads();
}

struct Args { const float* in[13]; float* out; unsigned char* ws; int ph_lo, ph_hi; };
static_assert(sizeof(Args) == 128, "Args has no padding");

__global__ void __launch_bounds__(NWAVES * 64, 2) mk_fwd(Args args) {
    extern __shared__ __attribute__((aligned(16))) unsigned char lds_raw[];
    Ctx C; C.lds = (LAS unsigned char*)lds_raw; C.tid = threadIdx.x; C.lane = C.tid & 63; C.wave = __builtin_amdgcn_readfirstlane(C.tid >> 6);
    C.gw = blockIdx.x * NWAVES + C.wave; C.NGW = gridDim.x * NWAVES;
    const int G = gridDim.x, bx = blockIdx.x;
    unsigned char* ws = args.ws;
    const float* x = args.in[0]; const float* cvec = args.in[1]; const float* w_ada = args.in[2]; const float* b_ada = args.in[3];
    const float* w1_gu = args.in[4]; const float* w1_down = args.in[5]; const float* w_in = args.in[6]; const float* qnw = args.in[7]; const float* knw = args.in[8];
    const float* conv_w = args.in[9]; const float* w_out = args.in[10]; const float* w2_gu = args.in[11]; const float* w2_down = args.in[12];
    float* mod = (float*)(ws + WS_MOD);
    bf16_t* W1GU = (bf16_t*)(ws + WS_W1GU); bf16_t* W1D = (bf16_t*)(ws + WS_W1D); bf16_t* WIN = (bf16_t*)(ws + WS_WIN); bf16_t* WOUT = (bf16_t*)(ws + WS_WOUT);
    bf16_t* W2GU = (bf16_t*)(ws + WS_W2GU); bf16_t* W2D = (bf16_t*)(ws + WS_W2D);
    bf16_t* H = (bf16_t*)(ws + WS_H); bf16_t* BIG = (bf16_t*)(ws + WS_BIG); float* X1 = (float*)(ws + WS_X1); bf16_t* AI = (bf16_t*)(ws + WS_AI);
    bf16_t* Qn = (bf16_t*)(ws + WS_QN); bf16_t* Kn = (bf16_t*)(ws + WS_KN); bf16_t* Vt = (bf16_t*)(ws + WS_VT);
    float* out = args.out;
    const int lo = args.ph_lo, hi = args.ph_hi;
#define IN(k) (lo <= (k) && (k) < hi)
#define SEAM(k) do { if (IN(k) && IN((k) + 1)) { cg::this_grid().sync(); } } while (0)

    if (IN(0)) {
        LAS unsigned* T = (LAS unsigned*)(C.lds + C.wave * 16384);
        constexpr int I_ADA = (D / 32) * (NMOD * D / 256);
        constexpr int I_GU = (D / 64) * (2 * FF / 64), I_DN = (FF / 64) * (D / 64), I_IN = (D / 64) * (NIN / 64), I_OUT = (D / 64) * (D / 64);
        constexpr int NITEMS = I_ADA + 2 * I_GU + 2 * I_DN + I_IN + I_OUT;
        for (int it = C.gw; it < NITEMS; it += C.NGW) {
            int r = it;
            if (r < I_ADA) { adaln_item(cvec, w_ada, b_ada, mod, r, C.lane); continue; } r -= I_ADA;
            if (r < I_GU) { tr_weight_item(w1_gu, D, 2 * FF, W1GU, true, r, T, C.lane); continue; } r -= I_GU;
            if (r < I_DN) { tr_weight_item(w1_down, FF, D, W1D, false, r, T, C.lane); continue; } r -= I_DN;
            if (r < I_IN) { tr_weight_item(w_in, D, NIN, WIN, false, r, T, C.lane); continue; } r -= I_IN;
            if (r < I_OUT) { tr_weight_item(w_out, D, D, WOUT, false, r, T, C.lane); continue; } r -= I_OUT;
            if (r < I_GU) { tr_weight_item(w2_gu, D, 2 * FF, W2GU, true, r, T, C.lane); continue; } r -= I_GU;
            tr_weight_item(w2_down, FF, D, W2D, false, r, T, C.lane);
        }
    }
    SEAM(0);
    if (IN(1)) norm_phase(C, x, mod, 0, H);
    SEAM(1);
    if (IN(2)) { pg8::Gemm g{H, W1GU, M, 2 * FF, D}; pg8::StaticOrder S; S.init(M, 2 * FF, G, bx); pg8::EpiSwiglu E{BIG, FF};
        pg8::gemm_phase<pg8::EpiSwiglu, pg8::StaticOrder, true, true>(C.lds, g, S, E); }
    SEAM(2);
    if (IN(3)) { pg8::Gemm g{BIG, W1D, M, D, FF}; pg8::StaticOrder S; S.init(M, D, G, bx); pg8::EpiResid E{x, X1, mod + 2 * D, 0.5f};
        pg8::gemm_phase<pg8::EpiResid, pg8::StaticOrder, true, true>(C.lds, g, S, E); }
    SEAM(3);
    if (IN(4)) norm_phase(C, X1, mod, 1, H);
    SEAM(4);
    if (IN(5)) { pg8::Gemm g{H, WIN, M, NIN, D}; pg8::StaticOrder S; S.init(M, NIN, G, bx); pg8::EpiStore E{BIG, NIN};
        pg8::gemm_phase<pg8::EpiStore, pg8::StaticOrder, true, true>(C.lds, g, S, E); }
    SEAM(5);
    if (IN(6)) prepass_phase(C, BIG, qnw, knw, conv_w, Qn, Kn, Vt, AI);
    SEAM(6);
    if (IN(7)) { for (int u = bx; u < BATCH * NHEAD * (SEQ / 256); u += G) { const int uu = BATCH * NHEAD * (SEQ / 256) - 1 - u; attn_unit(C, uu % (BATCH * NHEAD), uu / (BATCH * NHEAD), Qn, Kn, Vt, AI); } }
    SEAM(7);
    if (IN(8)) { pg8::Gemm g{AI, WOUT, M, D, D}; pg8::StaticOrder S; S.init(M, D, G, bx); pg8::EpiResid E{X1, out, mod + 5 * D, 1.0f};
        pg8::gemm_phase<pg8::EpiResid, pg8::StaticOrder, true, true>(C.lds, g, S, E); }
    SEAM(8);
    if (IN(9)) norm_phase(C, out, mod, 2, H);
    SEAM(9);
    if (IN(10)) { pg8::Gemm g{H, W2GU, M, 2 * FF, D}; pg8::StaticOrder S; S.init(M, 2 * FF, G, bx); pg8::EpiSwiglu E{BIG, FF};
        pg8::gemm_phase<pg8::EpiSwiglu, pg8::StaticOrder, true, true>(C.lds, g, S, E); }
    SEAM(10);
    if (IN(11)) { pg8::Gemm g{BIG, W2D, M, D, FF}; pg8::StaticOrder S; S.init(M, D, G, bx); pg8::EpiResid E{out, out, mod + 8 * D, 0.5f};
        pg8::gemm_phase<pg8::EpiResid, pg8::StaticOrder, true, true>(C.lds, g, S, E); }
#undef IN
#undef SEAM
}

extern "C" void kernel_launch(void* const* d_in, const int* in_sizes, int n_in, void* d_out, int out_size, void* d_ws, size_t ws_size, hipStream_t stream) {
    static int grid = 0;
    if (grid == 0) {
        if (n_in != 13 || in_sizes[0] != M * D || out_size != M * D || ws_size < WS_END) { fprintf(stderr, "kernel_launch: unexpected shapes (n_in %d, in0 %d, out %d, ws %zu)\n", n_in, n_in > 0 ? in_sizes[0] : -1, out_size, ws_size); grid = -1; return; }
        int dev = 0, cus = 0, per_cu = 0;
        if (hipGetDevice(&dev) != hipSuccess || hipDeviceGetAttribute(&cus, hipDeviceAttributeMultiprocessorCount, dev) != hipSuccess) { grid = -1; return; }
        if (hipFuncSetAttribute((const void*)mk_fwd, hipFuncAttributeMaxDynamicSharedMemorySize, LDS_BYTES) != hipSuccess) { fprintf(stderr, "kernel_launch: hipFuncSetAttribute failed\n"); grid = -1; return; }
        if (hipOccupancyMaxActiveBlocksPerMultiprocessor(&per_cu, (const void*)mk_fwd, NWAVES * 64, LDS_BYTES) != hipSuccess || per_cu < 1) { fprintf(stderr, "kernel_launch: occupancy query says %d\n", per_cu); per_cu = 1; }
        (void)hipGetLastError();
        grid = cus * per_cu;
    }
    if (grid < 0) return;
    (void)hipMemsetAsync((char*)d_ws + WS_MOD, 0, MOD_BYTES, stream);
    Args a{};
    for (int i = 0; i < 13; ++i) a.in[i] = (const float*)d_in[i];
    a.out = (float*)d_out; a.ws = (unsigned char*)d_ws;
#if MK_COOP
    a.ph_lo = 0; a.ph_hi = N_PHASES;
    void* kargs[] = {&a};
    hipError_t e = hipLaunchCooperativeKernel((const void*)mk_fwd, dim3(grid), dim3(NWAVES * 64), kargs, LDS_BYTES, stream);
    if (e != hipSuccess) fprintf(stderr, "cooperative launch failed: %s (grid %d)\n", hipGetErrorString(e), grid);
#else
    for (int p = 0; p < N_PHASES; ++p) { a.ph_lo = p; a.ph_hi = p + 1; hipLaunchKernelGGL(mk_fwd, dim3(grid), dim3(NWAVES * 64), LDS_BYTES, stream, a); }
#endif
}
```

```cpp
#include <hip/hip_runtime.h>
#include <hip/hip_cooperative_groups.h>
#include <cstdio>
#include <cstdint>
namespace cg = cooperative_groups;
#ifndef MK_COOP
#define MK_COOP 1
#endif
namespace pg8 {
#define PG8_LAS __attribute__((address_space(3)))
typedef unsigned short bf16_t;
typedef short bf16x8 __attribute__((ext_vector_type(8)));
typedef float f32x4 __attribute__((ext_vector_type(4)));
typedef unsigned u32x4 __attribute__((ext_vector_type(4)));
constexpr int BM = 256, BK = 64, HALF = 128, HTB = HALF * BK * 2  , STAGE_BYTES = 8 * HTB, NXCD = 8, WGM = 8;

__host__ __device__ __forceinline__ int lds_byte(int r, int c) { const int st = (r >> 4) * 2 + (c >> 5), rr = r & 15, cc = c & 31, ob = rr * 64 + cc * 2; return st * 1024 + (ob ^ (((ob >> 9) & 1) << 5)); }
__host__ __device__ __forceinline__ void stage_rc(int b, int& R, int& C) { const int st = b / 1024, sb = b % 1024, swz = sb ^ (((sb >> 9) & 1) << 5); R = (st >> 1) * 16 + swz / 64; C = (st & 1) * 32 + (swz % 64) / 2; }
__host__ __device__ __forceinline__ int perm32(int rho) { const int n = rho >> 4, i = rho & 15; return 8 * (i >> 2) + 4 * n + (i & 3); }

struct Unit { int pm, pn; };
struct Gemm { const bf16_t* A; const bf16_t* Bt; int M, N, K; };

struct StaticOrder {
    int nM, nN, nwg, G, c;
    __host__ __device__ void init(int M, int N, int G_, int c_) { nM = M / BM; nN = N / BM; nwg = nM * nN; G = G_; c = c_; }
    __host__ __device__ bool next(int i, Unit& u) const {
        const long L = (long)i * G + c; if (L >= nwg) return false;
        int wgid = (int)L; { const int q = nwg / NXCD, r = nwg % NXCD, xcd = wgid % NXCD, off = wgid / NXCD; wgid = (xcd < r ? xcd * (q + 1) : r * (q + 1) + (xcd - r) * q) + off; }
        const int nig = WGM * nN, gid = wgid / nig, fm = gid * WGM, gsz = (nM - fm) < WGM ? (nM - fm) : WGM;
        u.pm = fm + ((wgid % nig) % gsz); u.pn = (wgid % nig) / gsz; return true;
    }
    __device__ __forceinline__ void a_ready(const Unit&) const {}
    __device__ __forceinline__ void done(const Unit&) const {}
};

__device__ __forceinline__ unsigned cvt_pk_bf16(float lo, float hi) { unsigned r; asm volatile("v_cvt_pk_bf16_f32 %0, %1, %2" : "=v"(r) : "v"(lo), "v"(hi)); return r; }
typedef float f32x2 __attribute__((ext_vector_type(2)));
template <class Epi, class Sched, bool ALIGN_EPI = false, bool SP2 = false>
__device__ __forceinline__ void gemm_phase(PG8_LAS unsigned char* lds, const Gemm g, const Sched& S, const Epi& E) {
    const int tid = threadIdx.x, wid = __builtin_amdgcn_readfirstlane(tid >> 6), lane = tid & 63, wr = wid >> 2, wc = wid & 3, fr = lane & 15, fq = lane >> 4;
    const int K = g.K, nt = K / BK;
    unsigned voffA[2], voffB[2];
#pragma unroll
    for (int i = 0; i < 2; ++i) { int R, C; stage_rc(tid * 16 + i * 8192, R, C); const int Rb = Epi::PERM ? ((R & ~31) + perm32(R & 31)) : R;
        voffA[i] = (unsigned)(R * K + C) * 2u; voffB[i] = (unsigned)(Rb * K + C) * 2u; }
    const size_t kstep = (size_t)(BK * 2);
    const size_t hstep = (size_t)HALF * K * 2;
    const size_t tstep = 2 * hstep;
    const unsigned ldsw = (unsigned)wid * 1024u;
    const int aoff = lds_byte(wr * 64 + fr, fq * 8), boff = lds_byte(wc * 32 + fr, fq * 8);
#define PG8_SA(b, h) (((b) * 2 + (h)) * HTB)
#define PG8_SB(b, h) ((4 + (b) * 2 + (h)) * HTB)
#define PG8_STAGE(bufoff, gbase, voff) do { _Pragma("unroll") for (int _i = 0; _i < 2; ++_i) \
        __builtin_amdgcn_global_load_lds((const unsigned*)((const char*)(gbase) + (voff)[_i]), (PG8_LAS unsigned*)(lds + (bufoff) + ldsw + _i * 8192), 16, 0, 0); } while (0)
#define PG8_LDA(dst, b, h) do { _Pragma("unroll") for (int m = 0; m < 4; ++m) _Pragma("unroll") for (int k = 0; k < 2; ++k) dst[m][k] = *(const PG8_LAS bf16x8*)(lds + PG8_SA(b, h) + aoff + m * 2048 + k * 1024); } while (0)
#define PG8_LDB(dst, b, h) do { _Pragma("unroll") for (int n = 0; n < 2; ++n) _Pragma("unroll") for (int k = 0; k < 2; ++k) dst[n][k] = *(const PG8_LAS bf16x8*)(lds + PG8_SB(b, h) + boff + n * 2048 + k * 1024); } while (0)
#define PG8_MMA(ai, bj, At, Bt) do { __builtin_amdgcn_s_setprio(1); _Pragma("unroll") for (int m = 0; m < 4; ++m) _Pragma("unroll") for (int n = 0; n < 2; ++n) _Pragma("unroll") for (int k = 0; k < 2; ++k) \
        acc[ai][bj][m][n] = __builtin_amdgcn_mfma_f32_16x16x32_bf16(Bt[n][k], At[m][k], acc[ai][bj][m][n], 0, 0, 0); __builtin_amdgcn_s_setprio(0); } while (0)
#define PG8_WAIT_V(n) asm volatile("s_waitcnt vmcnt(" #n ")" ::: "memory")
#define PG8_WAIT_L(n) asm volatile("s_waitcnt lgkmcnt(" #n ")" ::: "memory")
#define PG8_BAR __builtin_amdgcn_s_barrier()
#define PG8_SCHED __builtin_amdgcn_sched_barrier(0)
    Unit cur, nxt; int ui = 0;
    if (!S.next(0, cur)) return;
    f32x4 acc[2][2][4][2];
#pragma unroll
    for (int a = 0; a < 2; ++a)
#pragma unroll
        for (int b = 0; b < 2; ++b)
#pragma unroll
            for (int m = 0; m < 4; ++m)
#pragma unroll
                for (int n = 0; n < 2; ++n) acc[a][b][m][n] = (f32x4){0.f, 0.f, 0.f, 0.f};
    bf16x8 At[4][2], B0[2][2], B1[2][2];
    const char* cA = (const char*)g.A + (size_t)cur.pm * tstep; const char* cB = (const char*)g.Bt + (size_t)cur.pn * tstep;
    S.a_ready(cur);
    if constexpr (SP2) {
        PG8_STAGE(PG8_SB(0, 0), cB, voffB); PG8_STAGE(PG8_SB(0, 1), cB + hstep, voffB); PG8_STAGE(PG8_SA(0, 0), cA, voffA); PG8_STAGE(PG8_SA(0, 1), cA + hstep, voffA);
        if (wr == 1) PG8_BAR;
        PG8_WAIT_V(2); PG8_BAR;
        PG8_STAGE(PG8_SB(1, 0), cB + kstep, voffB); PG8_STAGE(PG8_SA(1, 0), cA + kstep, voffA); PG8_STAGE(PG8_SB(1, 1), cB + hstep + kstep, voffB);
        PG8_WAIT_V(6); PG8_BAR;
    } else {
        PG8_STAGE(PG8_SB(0, 0), cB, voffB); PG8_STAGE(PG8_SA(0, 0), cA, voffA); PG8_STAGE(PG8_SB(0, 1), cB + hstep, voffB); PG8_STAGE(PG8_SA(0, 1), cA + hstep, voffA);
        if (wr == 1) PG8_BAR;
        PG8_WAIT_V(4); PG8_BAR;
        PG8_STAGE(PG8_SB(1, 0), cB + kstep, voffB); PG8_STAGE(PG8_SA(1, 0), cA + kstep, voffA); PG8_STAGE(PG8_SB(1, 1), cB + hstep + kstep, voffB);
        PG8_WAIT_V(6); PG8_BAR;
    }
    for (;;) {
        const bool has_next = S.next(ui + 1, nxt);
        const char* nA = has_next ? (const char*)g.A + (size_t)nxt.pm * tstep : cA; const char* nB = has_next ? (const char*)g.Bt + (size_t)nxt.pn * tstep : cB;
        for (int t = 0; t < nt; t += 2) {
            const bool last = (t == nt - 2);
            const char* a1 = cA + (size_t)(t + 1) * kstep;
            const char* a2 = last ? nA : cA + (size_t)(t + 2) * kstep; const char* b2 = last ? nB : cB + (size_t)(t + 2) * kstep;
            const char* a3 = a2 + kstep; const char* b3 = b2 + kstep;
            if (last && has_next) S.a_ready(nxt);
            if constexpr (SP2) {
            PG8_LDB(B0, 0, 0); PG8_LDB(B1, 0, 1); PG8_SCHED; PG8_LDA(At, 0, 0); PG8_STAGE(PG8_SA(1, 1), a1 + hstep, voffA);
            PG8_WAIT_V(8); PG8_WAIT_L(0); PG8_BAR; PG8_MMA(0, 0, At, B0); PG8_MMA(0, 1, At, B1); PG8_BAR; PG8_SCHED;
            PG8_LDA(At, 0, 1); PG8_STAGE(PG8_SB(0, 0), b2, voffB); PG8_STAGE(PG8_SB(0, 1), b2 + hstep, voffB); PG8_STAGE(PG8_SA(0, 0), a2, voffA);
            PG8_WAIT_V(8); PG8_WAIT_L(0); PG8_BAR; PG8_MMA(1, 0, At, B0); PG8_MMA(1, 1, At, B1); PG8_BAR; PG8_SCHED;
            PG8_LDB(B0, 1, 0); PG8_LDB(B1, 1, 1); PG8_SCHED; PG8_LDA(At, 1, 0); PG8_STAGE(PG8_SA(0, 1), a2 + hstep, voffA);
            PG8_WAIT_V(8); PG8_WAIT_L(0); PG8_BAR; PG8_MMA(0, 0, At, B0); PG8_MMA(0, 1, At, B1); PG8_BAR; PG8_SCHED;
            PG8_LDA(At, 1, 1); PG8_STAGE(PG8_SB(1, 0), b3, voffB); PG8_STAGE(PG8_SB(1, 1), b3 + hstep, voffB); PG8_STAGE(PG8_SA(1, 0), a3, voffA);
            PG8_WAIT_V(8); PG8_WAIT_L(0); PG8_BAR; PG8_MMA(1, 0, At, B0); PG8_MMA(1, 1, At, B1); PG8_BAR; PG8_SCHED;
            } else {
            PG8_LDB(B0, 0, 0); PG8_SCHED; PG8_LDA(At, 0, 0); PG8_STAGE(PG8_SA(1, 1), a1 + hstep, voffA);
            PG8_WAIT_L(8); PG8_BAR; PG8_WAIT_L(0); PG8_MMA(0, 0, At, B0); PG8_BAR; PG8_SCHED;
            PG8_LDB(B1, 0, 1); PG8_STAGE(PG8_SB(0, 0), b2, voffB);
            PG8_BAR; PG8_WAIT_L(0); PG8_MMA(0, 1, At, B1); PG8_BAR;
            PG8_LDA(At, 0, 1); PG8_STAGE(PG8_SA(0, 0), a2, voffA);
            PG8_BAR; PG8_WAIT_L(0); PG8_MMA(1, 0, At, B0); PG8_BAR; PG8_SCHED;
            PG8_STAGE(PG8_SB(0, 1), b2 + hstep, voffB);
            PG8_WAIT_V(6); PG8_BAR; PG8_MMA(1, 1, At, B1); PG8_BAR;
            PG8_LDB(B0, 1, 0); PG8_SCHED; PG8_LDA(At, 1, 0); PG8_STAGE(PG8_SA(0, 1), a2 + hstep, voffA);
            PG8_WAIT_L(8); PG8_BAR; PG8_WAIT_L(0); PG8_MMA(0, 0, At, B0); PG8_BAR; PG8_SCHED;
            PG8_LDB(B1, 1, 1); PG8_STAGE(PG8_SB(1, 0), b3, voffB);
            PG8_BAR; PG8_WAIT_L(0); PG8_MMA(0, 1, At, B1); PG8_BAR;
            PG8_LDA(At, 1, 1); PG8_STAGE(PG8_SA(1, 0), a3, voffA);
            PG8_BAR; PG8_WAIT_L(0); PG8_MMA(1, 0, At, B0); PG8_BAR; PG8_SCHED;
            PG8_STAGE(PG8_SB(1, 1), b3 + hstep, voffB);
            PG8_WAIT_V(6); PG8_BAR; PG8_MMA(1, 1, At, B1); PG8_BAR;
            }
        }
        if constexpr (ALIGN_EPI) { if (wr == 0) PG8_BAR; }
        if constexpr (!Epi::AFTER_DRAIN) { E(acc, cur, wr, wc, fr, fq); S.done(cur); }
        if (!has_next) break;
#pragma unroll
        for (int a = 0; a < 2; ++a)
#pragma unroll
            for (int b = 0; b < 2; ++b)
#pragma unroll
                for (int m = 0; m < 4; ++m)
#pragma unroll
                    for (int n = 0; n < 2; ++n) acc[a][b][m][n] = (f32x4){0.f, 0.f, 0.f, 0.f};
        cur = nxt; cA = nA; cB = nB; ++ui;
        if constexpr (ALIGN_EPI) { if (wr == 1) PG8_BAR; }
    }
    PG8_WAIT_V(0);
    if constexpr (!ALIGN_EPI) { if (wr == 0) PG8_BAR; }
    PG8_BAR;
    if constexpr (Epi::AFTER_DRAIN) { E.fused(acc, cur, wr, wc, fr, fq, lds, wid, lane); S.done(cur); }
#undef PG8_SA
#undef PG8_SB
#undef PG8_STAGE
#undef PG8_LDA
#undef PG8_LDB
#undef PG8_MMA
#undef PG8_WAIT_V
#undef PG8_WAIT_L
#undef PG8_BAR
#undef PG8_SCHED
}
}

constexpr int BATCH = 2, SEQ = 4096, D = 2048, M = BATCH * SEQ, FF = 5632, NIN = 6144, NHEAD = 8, HD = 128, NMOD = 9;
constexpr int NWAVES = 8;
constexpr float EPS = 1e-6f;
constexpr float LOG2E = 1.4426950408889634f;
constexpr float QSCALE = 0.08838834764831845f * LOG2E;
constexpr size_t MiB = 1u << 20;
constexpr size_t WS_MOD = 0, MOD_BYTES = (size_t)BATCH * NMOD * D * 4;
constexpr size_t WS_W1GU = 1 * MiB, WS_W1D = 45 * MiB, WS_WIN = 67 * MiB, WS_WOUT = 91 * MiB, WS_W2GU = 99 * MiB, WS_W2D = 143 * MiB;
constexpr size_t WS_H = 165 * MiB, WS_BIG = 197 * MiB, WS_X1 = 293 * MiB, WS_AI = 357 * MiB, WS_QN = 389 * MiB, WS_KN = 405 * MiB, WS_VT = 421 * MiB, WS_END = 437 * MiB;
constexpr int LDS_BYTES = 147456, LDSCTL_OFF = 131072;
constexpr size_t WS_CTL = 256 * 1024, CTL_ZERO_BYTES = 512 * 1024;
constexpr int N_PHASES = 12;

#define LAS __attribute__((address_space(3)))
typedef unsigned short bf16_t;
typedef float f32x4 __attribute__((ext_vector_type(4)));
typedef float f32x16 __attribute__((ext_vector_type(16)));
typedef unsigned u32x4 __attribute__((ext_vector_type(4)));
typedef short bf16x8 __attribute__((ext_vector_type(8)));
typedef float f32x2_t __attribute__((ext_vector_type(2)));
typedef __bf16 bf16x2_t __attribute__((ext_vector_type(2)));
#define LDS_WAIT() asm volatile("s_waitcnt lgkmcnt(0)" ::: "memory")
__device__ __forceinline__ unsigned pk2(float lo, float hi) { f32x2_t v = {lo, hi}; bf16x2_t b = __builtin_convertvector(v, bf16x2_t); return __builtin_bit_cast(unsigned, b); }
__device__ __forceinline__ float bflo(unsigned u) { return __uint_as_float(u << 16); }
__device__ __forceinline__ float bfhi(unsigned u) { return __uint_as_float(u & 0xffff0000u); }
__device__ __forceinline__ float wave_sum(float v) {
#pragma unroll
    for (int o = 1; o < 64; o <<= 1) v += __shfl_xor(v, o);
    return v;
}
__device__ __forceinline__ float silu_f(float v) { return v * __builtin_amdgcn_rcpf(1.0f + __builtin_amdgcn_exp2f(-v * LOG2E)); }

namespace pg8 {
struct EpiStore {
    static constexpr bool PERM = true, AFTER_DRAIN = false;
    bf16_t* O; int ldc;
    __device__ __forceinline__ void operator()(const f32x4 (&acc)[2][2][4][2], const Unit& u, int wr, int wc, int fr, int fq) const {
        const int row0 = u.pm * BM + wr * 64 + fr, col0 = u.pn * BM + wc * 32 + 8 * fq;
#pragma unroll
        for (int ai = 0; ai < 2; ++ai)
#pragma unroll
            for (int m = 0; m < 4; ++m) { bf16_t* rowp = O + (size_t)(row0 + ai * HALF + m * 16) * ldc + col0;
#pragma unroll
                for (int bj = 0; bj < 2; ++bj) { const f32x4 v0 = acc[ai][bj][m][0], v1 = acc[ai][bj][m][1];
                    u32x4 w; w.x = ::pk2(v0[0], v0[1]); w.y = ::pk2(v0[2], v0[3]); w.z = ::pk2(v1[0], v1[1]); w.w = ::pk2(v1[2], v1[3]);
                    *(u32x4*)(rowp + bj * HALF) = w; } }
    }
};
struct EpiSwiglu {
    static constexpr bool PERM = true, AFTER_DRAIN = false;
    bf16_t* O; int ldc;
    __device__ __forceinline__ void operator()(const f32x4 (&acc)[2][2][4][2], const Unit& u, int wr, int wc, int fr, int fq) const {
        const int row0 = u.pm * BM + wr * 64 + fr, col0 = u.pn * HALF + wc * 32 + 8 * fq;
#pragma unroll
        for (int ai = 0; ai < 2; ++ai)
#pragma unroll
            for (int m = 0; m < 4; ++m) { bf16_t* rowp = O + (size_t)(row0 + ai * HALF + m * 16) * ldc + col0;
                float r[8];
#pragma unroll
                for (int n = 0; n < 2; ++n)
#pragma unroll
                    for (int e = 0; e < 4; ++e) { const float g = acc[ai][0][m][n][e], up = acc[ai][1][m][n][e]; r[4 * n + e] = ::silu_f(g) * up; }
                u32x4 w; w.x = ::pk2(r[0], r[1]); w.y = ::pk2(r[2], r[3]); w.z = ::pk2(r[4], r[5]); w.w = ::pk2(r[6], r[7]);
                *(u32x4*)rowp = w; }
    }
};
struct EpiResid {
    static constexpr bool PERM = false, AFTER_DRAIN = false;
    const float* base; float* out; const float* gate; float scale;
    __device__ __forceinline__ void operator()(const f32x4 (&acc)[2][2][4][2], const Unit& u, int wr, int wc, int fr, int fq) const {
        const int row0 = u.pm * BM + wr * 64 + fr, col0 = u.pn * BM + wc * 32 + 4 * fq;
        const float* gp = gate + (size_t)((u.pm * BM) / SEQ) * (NMOD * D) + col0;
        f32x4 gv[2][2];
#pragma unroll
        for (int bj = 0; bj < 2; ++bj)
#pragma unroll
            for (int n = 0; n < 2; ++n) gv[bj][n] = *(const f32x4*)(gp + bj * HALF + n * 16) * scale;
#pragma unroll
        for (int ai = 0; ai < 2; ++ai)
#pragma unroll
            for (int m = 0; m < 4; ++m) { const size_t off = (size_t)(row0 + ai * HALF + m * 16) * D + col0;
#pragma unroll
                for (int bj = 0; bj < 2; ++bj)
#pragma unroll
                    for (int n = 0; n < 2; ++n) { const f32x4 bs = *(const f32x4*)(base + off + bj * HALF + n * 16);
                        *(f32x4*)(out + off + bj * HALF + n * 16) = bs + gv[bj][n] * acc[ai][bj][m][n]; } }
    }
};
}

struct Ctx {
    LAS unsigned char* lds; int tid, lane, wave, gw, NGW;
};

__device__ __forceinline__ void tr_item_f32(const float* __restrict__ src, int N, int k0, int n0, bf16_t* __restrict__ dst, size_t dpitch, size_t drow0, LAS unsigned* T, int lane) {
    const int nq = lane & 15, kr = lane >> 4;
    const float* s = src + (size_t)(k0 + 2 * kr) * N + n0 + 4 * nq;
    f32x4 a[8], b[8];
#pragma unroll
    for (int it = 0; it < 8; ++it) { a[it] = __builtin_nontemporal_load((const f32x4*)(s + (size_t)(8 * it) * N)); b[it] = __builtin_nontemporal_load((const f32x4*)(s + (size_t)(8 * it + 1) * N)); }
#pragma unroll
    for (int it = 0; it < 8; ++it) { const int kp = it * 4 + kr;
#pragma unroll
        for (int j = 0; j < 4; ++j) T[(4 * nq + j) * 33 + kp] = pk2(a[it][j], b[it][j]); }
    LDS_WAIT();
    const int c = lane & 7, nn = lane >> 3;
#pragma unroll
    for (int jj = 0; jj < 8; ++jj) { const int n = nn + 8 * jj; const LAS unsigned* p = T + n * 33 + 4 * c;
        u32x4 o; o.x = p[0]; o.y = p[1]; o.z = p[2]; o.w = p[3];
        *(u32x4*)(dst + (drow0 + n) * dpitch + k0 + 8 * c) = o; }
    LDS_WAIT();
}
__device__ __forceinline__ void tr_item_bf16(const bf16_t* __restrict__ src, size_t spitch, bf16_t* __restrict__ dst, size_t dpitch, LAS unsigned* T, int lane) {
    const int dq = lane & 7, kr = lane >> 3;
    const bf16_t* s = src + (size_t)(2 * kr) * spitch + 8 * dq;
    u32x4 a[4], b[4];
#pragma unroll
    for (int it = 0; it < 4; ++it) { a[it] = *(const u32x4*)(s + (size_t)(16 * it) * spitch); b[it] = *(const u32x4*)(s + (size_t)(16 * it + 1) * spitch); }
#pragma unroll
    for (int it = 0; it < 4; ++it) { const int kp = it * 8 + kr;
#pragma unroll
        for (int j = 0; j < 4; ++j) { const unsigned x = a[it][j], y = b[it][j];
            T[(8 * dq + 2 * j) * 33 + kp] = (x & 0xffffu) | (y << 16);
            T[(8 * dq + 2 * j + 1) * 33 + kp] = (x >> 16) | (y & 0xffff0000u); } }
    LDS_WAIT();
    const int c = lane & 7, nn = lane >> 3;
#pragma unroll
    for (int jj = 0; jj < 8; ++jj) { const int n = nn + 8 * jj; const LAS unsigned* p = T + n * 33 + 4 * c;
        u32x4 o; o.x = p[0]; o.y = p[1]; o.z = p[2]; o.w = p[3];
        *(u32x4*)(dst + (size_t)n * dpitch + 8 * c) = o; }
    LDS_WAIT();
}

__device__ __forceinline__ void tr_weight_item(const float* W, int K, int N, bf16_t* WT, bool gu, int item, LAS unsigned* T, int lane) {
    const int nblk = N / 64, kb = item / nblk, nb = item % nblk, n0 = nb * 64;
    size_t drow0 = n0;
    if (gu) { const int half = (n0 >= FF) ? 1 : 0, j = n0 - half * FF; drow0 = (size_t)(j >> 7) * 256 + half * 128 + (j & 127); }
    tr_item_f32(W, N, kb * 64, n0, WT, (size_t)K, drow0, T, lane);
}

__device__ __forceinline__ void adaln_item(const float* __restrict__ c, const float* __restrict__ w_ada, const float* __restrict__ b_ada, float* mod, int item, int lane) {
    constexpr int NC = NMOD * D;
    const int cb = item % (NC / 256), kc = item / (NC / 256), k0 = kc * 32, n0 = cb * 256 + 4 * lane;
    float s0 = 0.f, s1 = 0.f;
    if (lane < 32) { s0 = silu_f(c[k0 + lane]); s1 = silu_f(c[D + k0 + lane]); }
    f32x4 a0 = {0.f, 0.f, 0.f, 0.f}, a1 = {0.f, 0.f, 0.f, 0.f};
    const float* wp = w_ada + (size_t)k0 * NC + n0;
#pragma unroll 8
    for (int kk = 0; kk < 32; ++kk) { const f32x4 w = __builtin_nontemporal_load((const f32x4*)(wp + (size_t)kk * NC)); const float c0 = __shfl(s0, kk), c1 = __shfl(s1, kk); a0 += w * c0; a1 += w * c1; }
    if (kc == 0) { const f32x4 bv = *(const f32x4*)(b_ada + n0); a0 += bv; a1 += bv; }
#pragma unroll
    for (int e = 0; e < 4; ++e) { unsafeAtomicAdd(mod + n0 + e, a0[e]); unsafeAtomicAdd(mod + NC + n0 + e, a1[e]); }
}

__device__ __forceinline__ void norm_phase(const Ctx& C, const float* __restrict__ X, const float* __restrict__ mod, int mi, bf16_t* __restrict__ H) {
    for (int m = C.gw; m < M; m += C.NGW) {
        const float* xr = X + (size_t)m * D + 8 * C.lane;
        f32x4 v[4][2]; float ss = 0.f;
#pragma unroll
        for (int j = 0; j < 4; ++j) { v[j][0] = *(const f32x4*)(xr + 512 * j); v[j][1] = *(const f32x4*)(xr + 512 * j + 4);
            ss += (v[j][0][0] * v[j][0][0] + v[j][0][1] * v[j][0][1]) + (v[j][0][2] * v[j][0][2] + v[j][0][3] * v[j][0][3]);
            ss += (v[j][1][0] * v[j][1][0] + v[j][1][1] * v[j][1][1]) + (v[j][1][2] * v[j][1][2] + v[j][1][3] * v[j][1][3]); }
        const float rstd = __builtin_amdgcn_rsqf(wave_sum(ss) * (1.0f / D) + EPS);
        const float* sh = mod + (size_t)(m / SEQ) * (NMOD * D) + (size_t)(3 * mi) * D + 8 * C.lane; const float* sc = sh + D;
        bf16_t* hr = H + (size_t)m * D + 8 * C.lane;
#pragma unroll
        for (int j = 0; j < 4; ++j) { f32x4 r0 = v[j][0] * rstd * (*(const f32x4*)(sc + 512 * j) + 1.0f) + *(const f32x4*)(sh + 512 * j);
            f32x4 r1 = v[j][1] * rstd * (*(const f32x4*)(sc + 512 * j + 4) + 1.0f) + *(const f32x4*)(sh + 512 * j + 4);
            u32x4 w; w.x = pk2(r0[0], r0[1]); w.y = pk2(r0[2], r0[3]); w.z = pk2(r1[0], r1[1]); w.w = pk2(r1[2], r1[3]);
            *(u32x4*)(hr + 512 * j) = w; }
    }
}

__device__ __forceinline__ void prepass_phase(const Ctx& C, const bf16_t* __restrict__ PROJ, const float* __restrict__ qw, const float* __restrict__ kw, const float* __restrict__ convw,
                                              bf16_t* __restrict__ Qn, bf16_t* __restrict__ Kn, bf16_t* __restrict__ Vt, bf16_t* __restrict__ AI) {
    LAS unsigned* T = (LAS unsigned*)(C.lds + C.wave * 16384);
    constexpr int I_ROW = M, I_VT = BATCH * NHEAD * (SEQ / 64) * 2, I_CONV = BATCH * (SEQ / 8) * 2;
    for (int it = C.gw; it < I_ROW + I_VT + I_CONV; it += C.NGW) {
        if (it < I_ROW) {
            const int m = it, b = m / SEQ, s = m % SEQ, lane = C.lane;
            const bf16_t* p = PROJ + (size_t)m * NIN + 32 * lane;
            u32x4 x[4]; float f[32]; float ss = 0.f;
#pragma unroll
            for (int j = 0; j < 4; ++j) x[j] = *(const u32x4*)(p + 8 * j);
#pragma unroll
            for (int j = 0; j < 4; ++j)
#pragma unroll
                for (int e = 0; e < 4; ++e) { f[8 * j + 2 * e] = bflo(x[j][e]); f[8 * j + 2 * e + 1] = bfhi(x[j][e]); }
#pragma unroll
            for (int e = 0; e < 32; ++e) ss += f[e] * f[e];
            ss += __shfl_xor(ss, 1); ss += __shfl_xor(ss, 2);
            const int head = lane >> 2, d0 = (lane & 3) * 32; const bool isq = head < 8;
            const float rs = __builtin_amdgcn_rsqf(ss * (1.0f / HD) + EPS) * (isq ? QSCALE : 1.0f);
            const float* g = (isq ? qw : kw) + d0;
            bf16_t* o = (isq ? Qn : Kn) + (((size_t)b * NHEAD + (head & 7)) * SEQ + s) * HD + d0;
#pragma unroll
            for (int j = 0; j < 4; ++j) { const f32x4 g0 = *(const f32x4*)(g + 8 * j), g1 = *(const f32x4*)(g + 8 * j + 4);
                u32x4 w; w.x = pk2(f[8 * j] * rs * g0[0], f[8 * j + 1] * rs * g0[1]); w.y = pk2(f[8 * j + 2] * rs * g0[2], f[8 * j + 3] * rs * g0[3]);
                w.z = pk2(f[8 * j + 4] * rs * g1[0], f[8 * j + 5] * rs * g1[1]); w.w = pk2(f[8 * j + 6] * rs * g1[2], f[8 * j + 7] * rs * g1[3]);
                *(u32x4*)(o + 8 * j) = w; }
        } else if (it < I_ROW + I_VT) {
            const int r = it - I_ROW, dh = r & 1, sb = (r >> 1) % (SEQ / 64), bh = (r >> 1) / (SEQ / 64), b = bh / NHEAD, hh = bh % NHEAD;
            const bf16_t* src = PROJ + ((size_t)b * SEQ + sb * 64) * NIN + 2048 + hh * HD + dh * 64;
            bf16_t* dst = Vt + ((size_t)bh * HD + dh * 64) * SEQ + sb * 64;
            tr_item_bf16(src, NIN, dst, SEQ, T, C.lane);
        } else {
            const int r = it - I_ROW - I_VT, half = r & 1, tb = (r >> 1) % (SEQ / 8), b = (r >> 1) / (SEQ / 8), t0 = tb * 8, ch = half * 512 + 8 * C.lane;
            float w0[8], w1[8], w2[8];
#pragma unroll
            for (int e = 0; e < 8; ++e) { w0[e] = convw[ch + e]; w1[e] = convw[1024 + ch + e]; w2[e] = convw[2048 + ch + e]; }
            const bf16_t* p = PROJ + ((size_t)b * SEQ + t0) * NIN + ch;
            u32x4 gb[8], gc[10], uu[10];
#pragma unroll
            for (int i = 0; i < 10; ++i) { if (t0 + i - 2 >= 0) { gc[i] = *(const u32x4*)(p + (ptrdiff_t)(i - 2) * NIN + 4096); uu[i] = *(const u32x4*)(p + (ptrdiff_t)(i - 2) * NIN + 5120); }
                else { gc[i] = (u32x4){0u, 0u, 0u, 0u}; uu[i] = (u32x4){0u, 0u, 0u, 0u}; } }
#pragma unroll
            for (int i = 0; i < 8; ++i) gb[i] = *(const u32x4*)(p + (size_t)i * NIN + 3072);
            float c1[8], c2[8];
#pragma unroll
            for (int i = 0; i < 10; ++i) { float cu[8];
#pragma unroll
                for (int e = 0; e < 4; ++e) { cu[2 * e] = bflo(gc[i][e]) * bflo(uu[i][e]); cu[2 * e + 1] = bfhi(gc[i][e]) * bfhi(uu[i][e]); }
                if (i >= 2) { float y[8];
#pragma unroll
                    for (int e = 0; e < 4; ++e) { y[2 * e] = bflo(gb[i - 2][e]) * (w0[2 * e] * c2[2 * e] + w1[2 * e] * c1[2 * e] + w2[2 * e] * cu[2 * e]);
                        y[2 * e + 1] = bfhi(gb[i - 2][e]) * (w0[2 * e + 1] * c2[2 * e + 1] + w1[2 * e + 1] * c1[2 * e + 1] + w2[2 * e + 1] * cu[2 * e + 1]); }
                    u32x4 w; w.x = pk2(y[0], y[1]); w.y = pk2(y[2], y[3]); w.z = pk2(y[4], y[5]); w.w = pk2(y[6], y[7]);
                    *(u32x4*)(AI + ((size_t)b * SEQ + t0 + i - 2) * D + 1024 + ch) = w; }
#pragma unroll
                for (int e = 0; e < 8; ++e) { c2[e] = (i >= 1) ? c1[e] : 0.f; c1[e] = cu[e]; } }
        }
    }
}

#define MFMA32(a, b, c) __builtin_amdgcn_mfma_f32_32x32x16_bf16((a), (b), (c), 0, 0, 0)
constexpr int KPITCH = 272, VPITCH = 144, LDS_KT = 0, LDS_VT = 64 * KPITCH, LDS_FLAG = LDS_VT + 128 * VPITCH;
__device__ __forceinline__ void attn_unit(const Ctx& C, int bh, int qb, const bf16_t* __restrict__ Qn, const bf16_t* __restrict__ Kn, const bf16_t* __restrict__ Vt, bf16_t* __restrict__ AI) {
    const int lane = C.lane, r = lane & 31, h = lane >> 5, tid = C.tid;
    const int t0 = qb * 256 + C.wave * 32, t = t0 + r;
    bf16x8 qf[8];
    { const bf16_t* Qw = Qn + ((size_t)bh * SEQ + t) * HD + 8 * h;
#pragma unroll
      for (int c = 0; c < 8; ++c) qf[c] = *(const bf16x8*)(Qw + 16 * c); }
    f32x16 o[4];
#pragma unroll
    for (int db = 0; db < 4; ++db)
#pragma unroll
        for (int i = 0; i < 16; ++i) o[db][i] = 0.f;
    float R = 0.f;
    const int jlast = qb * 4 + 3, jw = t0 >> 6;
    const int ii = (r & 3) + 4 * (r >> 3), kvm = 16 * (ii >> 3) + 8 * ((r >> 2) & 1) + (ii & 7);
    const LAS unsigned char* Kl = C.lds + LDS_KT + kvm * KPITCH + h * 16;
    const LAS unsigned char* Vl = C.lds + LDS_VT + r * VPITCH + h * 16;
    const bf16_t* Kg = Kn + (size_t)bh * SEQ * HD; const bf16_t* Vg = Vt + (size_t)bh * HD * SEQ;
    u32x4 kreg[2], vreg[2];
#define ATT_PREFETCH(j) do { _Pragma("unroll") for (int i_ = 0; i_ < 2; ++i_) { const int p_ = tid + 512 * i_; \
        kreg[i_] = *(const u32x4*)(Kg + (size_t)(j) * 64 * HD + (size_t)p_ * 8); \
        vreg[i_] = *(const u32x4*)(Vg + (size_t)(p_ >> 3) * SEQ + (j) * 64 + (p_ & 7) * 8); } } while (0)
    ATT_PREFETCH(jlast);
    LAS unsigned* wflag = (LAS unsigned*)(C.lds + LDS_FLAG);
    if (lane == 0) wflag[C.wave] = 0u;
    for (int j = jlast; j >= 0; --j) {
        __syncthreads();
        { const u32x4 f0 = *(const LAS u32x4*)wflag, f1 = *(const LAS u32x4*)(wflag + 4); if ((f0.x & f0.y & f0.z & f0.w & f1.x & f1.y & f1.z & f1.w) != 0u) break; }
#pragma unroll
        for (int i_ = 0; i_ < 2; ++i_) { const int p_ = tid + 512 * i_;
            *(LAS u32x4*)(C.lds + LDS_KT + (p_ >> 4) * KPITCH + (p_ & 15) * 16) = kreg[i_];
            *(LAS u32x4*)(C.lds + LDS_VT + (p_ >> 3) * VPITCH + (p_ & 7) * 16) = vreg[i_]; }
        __syncthreads();
        if (j > 0) ATT_PREFETCH(j - 1);
        if (j <= jw) {
            f32x16 p0, p1;
#pragma unroll
            for (int i = 0; i < 16; ++i) { p0[i] = 0.f; p1[i] = 0.f; }
#pragma unroll
            for (int c = 0; c < 8; ++c) { const bf16x8 k0 = *(const LAS bf16x8*)(Kl + c * 32), k1 = *(const LAS bf16x8*)(Kl + 32 * KPITCH + c * 32);
                p0 = MFMA32(k0, qf[c], p0); p1 = MFMA32(k1, qf[c], p1); }
            const bool diag = (j == jw);
            const int kvb = 64 * j + 8 * h;
            float lf0[16], lf1[16];
#pragma unroll
            for (int i = 0; i < 16; ++i) {
                const int kv = kvb + 16 * (i >> 3) + (i & 7);
                { const float z = p0[i]; float l = -(fmaxf(z, 0.f) + __builtin_amdgcn_logf(1.0f + __builtin_amdgcn_exp2f(-fabsf(z)))); if (diag && kv >= t) l = 0.f; lf0[i] = l; }
                { const float z = p1[i]; float l = -(fmaxf(z, 0.f) + __builtin_amdgcn_logf(1.0f + __builtin_amdgcn_exp2f(-fabsf(z)))); if (diag && kv + 32 >= t) l = 0.f; lf1[i] = l; }
            }
            float gs[4], og[4];
            gs[0] = ((lf0[0] + lf0[1]) + (lf0[2] + lf0[3])) + ((lf0[4] + lf0[5]) + (lf0[6] + lf0[7]));
            gs[1] = ((lf0[8] + lf0[9]) + (lf0[10] + lf0[11])) + ((lf0[12] + lf0[13]) + (lf0[14] + lf0[15]));
            gs[2] = ((lf1[0] + lf1[1]) + (lf1[2] + lf1[3])) + ((lf1[4] + lf1[5]) + (lf1[6] + lf1[7]));
            gs[3] = ((lf1[8] + lf1[9]) + (lf1[10] + lf1[11])) + ((lf1[12] + lf1[13]) + (lf1[14] + lf1[15]));
#pragma unroll
            for (int g = 0; g < 4; ++g) og[g] = __shfl_xor(gs[g], 32);
            float off[4]; float run = R;
#pragma unroll
            for (int g = 3; g >= 0; --g) { off[g] = run + (h == 0 ? og[g] : 0.f); run += gs[g] + og[g]; }
            R = run;
            { const bool dead = __builtin_amdgcn_ballot_w64(!(R < -160.0f)) == 0ull; if (lane == 0) wflag[C.wave] = dead ? 1u : 0u; }
#pragma unroll
            for (int g = 0; g < 2; ++g) { float c = off[g];
#pragma unroll
                for (int e = 7; e >= 0; --e) { const int i = 8 * g + e; c += lf0[i]; const int kv = kvb + 16 * g + e; float a = __builtin_amdgcn_exp2f(p0[i] + c); if (diag && kv >= t) a = 0.f; p0[i] = a; } }
#pragma unroll
            for (int g = 0; g < 2; ++g) { float c = off[2 + g];
#pragma unroll
                for (int e = 7; e >= 0; --e) { const int i = 8 * g + e; c += lf1[i]; const int kv = kvb + 32 + 16 * g + e; float a = __builtin_amdgcn_exp2f(p1[i] + c); if (diag && kv >= t) a = 0.f; p1[i] = a; } }
            bf16x8 pa[4];
            { u32x4 w;
              w.x = pk2(p0[0], p0[1]); w.y = pk2(p0[2], p0[3]); w.z = pk2(p0[4], p0[5]); w.w = pk2(p0[6], p0[7]); pa[0] = __builtin_bit_cast(bf16x8, w);
              w.x = pk2(p0[8], p0[9]); w.y = pk2(p0[10], p0[11]); w.z = pk2(p0[12], p0[13]); w.w = pk2(p0[14], p0[15]); pa[1] = __builtin_bit_cast(bf16x8, w);
              w.x = pk2(p1[0], p1[1]); w.y = pk2(p1[2], p1[3]); w.z = pk2(p1[4], p1[5]); w.w = pk2(p1[6], p1[7]); pa[2] = __builtin_bit_cast(bf16x8, w);
              w.x = pk2(p1[8], p1[9]); w.y = pk2(p1[10], p1[11]); w.z = pk2(p1[12], p1[13]); w.w = pk2(p1[14], p1[15]); pa[3] = __builtin_bit_cast(bf16x8, w); }
#pragma unroll
            for (int db = 0; db < 4; ++db)
#pragma unroll
                for (int s = 0; s < 4; ++s) { const bf16x8 vf = *(const LAS bf16x8*)(Vl + db * 32 * VPITCH + s * 32); o[db] = MFMA32(pa[s], vf, o[db]); }
        }
    }
#undef ATT_PREFETCH
    const int b = bh / NHEAD, hh = bh % NHEAD;
#pragma unroll
    for (int i = 0; i < 16; ++i) { const int q = (i & 3) + 8 * (i >> 2) + 4 * h; bf16_t* op = AI + ((size_t)b * SEQ + t0 + q) * D + hh * HD + r;
#pragma unroll
        for (int db = 0; db < 4; ++db) op[32 * db] = (bf16_t)(pk2(o[db][i], 0.f) & 0xffffu); }
    __syncthreads();
}

#define XB_TMO      128
#define XB_XCNT(j)  (256  + 64 * (j))
#define XB_XSUB(j)  (1280 + 64 * (j))
#define XB_XGEN(j)  (2304 + 64 * (j))
#define XB_TOP      3328
#define XB_TOPGEN   3392
#define XCD_BAR_WORDS 3456
#define XB_SPIN_CAP (1u << 18)

__device__ __forceinline__ unsigned xb_ld(unsigned* p)              { return __hip_atomic_load(p, __ATOMIC_RELAXED, __HIP_MEMORY_SCOPE_AGENT); }
__device__ __forceinline__ unsigned xb_add(unsigned* p, unsigned v) { return __hip_atomic_fetch_add(p, v, __ATOMIC_RELAXED, __HIP_MEMORY_SCOPE_AGENT); }
__device__ __forceinline__ unsigned xb_xcc_id() { return (unsigned)__builtin_amdgcn_s_getreg((3 << 11) | 20) & 0xFu; }
#define XB_SPIN(cond, bar) do { unsigned _sp = 0; while (cond) { __builtin_amdgcn_s_sleep(1); \
    if ((++_sp & 255u) == 0u) { if (xb_ld(&(bar)[XB_TMO])) break; if (_sp > XB_SPIN_CAP) { atomicAdd(&(bar)[XB_TMO], 1u); break; } } } } while (0)

struct XcdBarrier {
    unsigned* bar; unsigned x;
    volatile LAS unsigned* st;
};

__device__ __forceinline__ XcdBarrier xcd_barrier_post(unsigned* bar, volatile LAS unsigned* st) {
    XcdBarrier b; b.bar = bar; b.x = xb_xcc_id(); b.st = st;
    if (threadIdx.x == 0) (void)xb_add(&bar[XB_XCNT(b.x)], 1u);
    return b;
}
__device__ __forceinline__ void xcd_barrier_complete(unsigned* bar, unsigned x, unsigned& nloc, unsigned& nx) {
    const unsigned G = gridDim.x * gridDim.y * gridDim.z;
    unsigned sum, cnt, mine, sp = 0u;
    for (;;) {
        sum = 0u; cnt = 0u; mine = 0u;
#pragma unroll
        for (unsigned j = 0; j < 16; ++j) { const unsigned c = xb_ld(&bar[XB_XCNT(j)]); sum += c; cnt += (c > 0u) ? 1u : 0u; mine = (j == x) ? c : mine; }
        if (sum == G) break;
        __builtin_amdgcn_s_sleep(1);
        if ((++sp & 255u) == 0u) { if (xb_ld(&bar[XB_TMO])) break; if (sp > XB_SPIN_CAP) { atomicAdd(&bar[XB_TMO], 1u); break; } }
    }
    nloc = mine > 0u ? mine : 1u; nx = cnt > 0u ? cnt : 1u;
}

__device__ __forceinline__ void xcd_barrier(const XcdBarrier& b) {
    asm volatile("s_waitcnt vmcnt(0)" ::: "memory");
    __syncthreads();
    if (threadIdx.x == 0) {
        unsigned* bar = b.bar;
        __builtin_amdgcn_s_waitcnt(0);
        unsigned nloc = b.st[0], nx = b.st[1];
        if (nloc == 0u) { xcd_barrier_complete(bar, b.x, nloc, nx); b.st[0] = nloc; b.st[1] = nx; }
        const unsigned old = xb_add(&bar[XB_XSUB(b.x)], 1u);
        const unsigned gen = old / nloc;
        if (old + 1u == (gen + 1u) * nloc) {
            __builtin_amdgcn_fence(__ATOMIC_RELEASE, "agent");
            asm volatile("s_waitcnt vmcnt(0)" ::: "memory");
            const unsigned og = xb_add(&bar[XB_TOP], 1u);
            const unsigned tg = og / nx;
            if (og + 1u == (tg + 1u) * nx) xb_add(&bar[XB_TOPGEN], 1u);
            else XB_SPIN(xb_ld(&bar[XB_TOPGEN]) == tg, bar);
            __builtin_amdgcn_fence(__ATOMIC_ACQUIRE, "agent");
            xb_add(&bar[XB_XGEN(b.x)], 1u);
            asm volatile("s_waitcnt vmcnt(0)" ::: "memory");
        } else {
            XB_SPIN(xb_ld(&bar[XB_XGEN(b.x)]) == gen, bar);
            __builtin_amdgcn_fence(__ATOMIC_ACQUIRE, "agent");
            asm volatile("s_waitcnt vmcnt(0)" ::: "memory");
        }
    }
    __syncthreads();
}

struct Args { const float* in[13]; float* out; unsigned char* ws; int ph_lo, ph_hi; };
static_assert(sizeof(Args) == 128, "Args has no padding");

__global__ void __launch_bounds__(NWAVES * 64, 2) mk_fwd(Args args) {
    extern __shared__ __attribute__((aligned(16))) unsigned char lds_raw[];
    Ctx C; C.lds = (LAS unsigned char*)lds_raw; C.tid = threadIdx.x; C.lane = C.tid & 63; C.wave = __builtin_amdgcn_readfirstlane(C.tid >> 6);
    C.gw = blockIdx.x * NWAVES + C.wave; C.NGW = gridDim.x * NWAVES;
    const int G = gridDim.x, bx = blockIdx.x;
    unsigned char* ws = args.ws;
    const float* x = args.in[0]; const float* cvec = args.in[1]; const float* w_ada = args.in[2]; const float* b_ada = args.in[3];
    const float* w1_gu = args.in[4]; const float* w1_down = args.in[5]; const float* w_in = args.in[6]; const float* qnw = args.in[7]; const float* knw = args.in[8];
    const float* conv_w = args.in[9]; const float* w_out = args.in[10]; const float* w2_gu = args.in[11]; const float* w2_down = args.in[12];
    float* mod = (float*)(ws + WS_MOD);
    bf16_t* W1GU = (bf16_t*)(ws + WS_W1GU); bf16_t* W1D = (bf16_t*)(ws + WS_W1D); bf16_t* WIN = (bf16_t*)(ws + WS_WIN); bf16_t* WOUT = (bf16_t*)(ws + WS_WOUT);
    bf16_t* W2GU = (bf16_t*)(ws + WS_W2GU); bf16_t* W2D = (bf16_t*)(ws + WS_W2D);
    bf16_t* H = (bf16_t*)(ws + WS_H); bf16_t* BIG = (bf16_t*)(ws + WS_BIG); float* X1 = (float*)(ws + WS_X1); bf16_t* AI = (bf16_t*)(ws + WS_AI);
    bf16_t* Qn = (bf16_t*)(ws + WS_QN); bf16_t* Kn = (bf16_t*)(ws + WS_KN); bf16_t* Vt = (bf16_t*)(ws + WS_VT);
    float* out = args.out;
    const int lo = args.ph_lo, hi = args.ph_hi;
    if (C.tid < 64) ((LAS unsigned*)(C.lds + LDSCTL_OFF))[C.tid] = 0u;
    __syncthreads();
    XcdBarrier bar = xcd_barrier_post((unsigned*)(ws + WS_CTL), (volatile LAS unsigned*)(C.lds + LDSCTL_OFF + 32));
#ifndef PROBE_REP
#define PROBE_REP -1
#endif
#define NREP(k) ((k) == PROBE_REP ? 2 : 1)
#define IN(k) (lo <= (k) && (k) < hi)
#define SEAM(k) do { if (IN(k) && IN((k) + 1)) { if ((k) == 0) cg::this_grid().sync(); else xcd_barrier(bar); } } while (0)

    if (IN(0)) {
        LAS unsigned* T = (LAS unsigned*)(C.lds + C.wave * 16384);
        constexpr int I_ADA = (D / 32) * (NMOD * D / 256);
        constexpr int I_GU = (D / 64) * (2 * FF / 64), I_DN = (FF / 64) * (D / 64), I_IN = (D / 64) * (NIN / 64), I_OUT = (D / 64) * (D / 64);
        constexpr int NITEMS = I_ADA + 2 * I_GU + 2 * I_DN + I_IN + I_OUT;
        for (int rep = 0; rep < NREP(0); ++rep)
        for (int it = C.gw + (rep ? ((I_ADA + C.NGW - 1) / C.NGW) * C.NGW : 0); it < NITEMS; it += C.NGW) {
            int r = it;
            if (r < I_ADA) { adaln_item(cvec, w_ada, b_ada, mod, r, C.lane); continue; } r -= I_ADA;
            if (r < I_GU) { tr_weight_item(w1_gu, D, 2 * FF, W1GU, true, r, T, C.lane); continue; } r -= I_GU;
            if (r < I_DN) { tr_weight_item(w1_down, FF, D, W1D, false, r, T, C.lane); continue; } r -= I_DN;
            if (r < I_IN) { tr_weight_item(w_in, D, NIN, WIN, false, r, T, C.lane); continue; } r -= I_IN;
            if (r < I_OUT) { tr_weight_item(w_out, D, D, WOUT, false, r, T, C.lane); continue; } r -= I_OUT;
            if (r < I_GU) { tr_weight_item(w2_gu, D, 2 * FF, W2GU, true, r, T, C.lane); continue; } r -= I_GU;
            tr_weight_item(w2_down, FF, D, W2D, false, r, T, C.lane);
        }
    }
    SEAM(0);
    if (IN(1)) for (int rep = 0; rep < NREP(1); ++rep) norm_phase(C, x, mod, 0, H);
    SEAM(1);
#ifdef PROBE_SYNC
    for (int q_ = 0; q_ < PROBE_SYNC; ++q_) cg::this_grid().sync();
#endif
    if (IN(2)) _Pragma("unroll") for (int rep = 0; rep < NREP(2); ++rep) { pg8::Gemm g{H, W1GU, M, 2 * FF, D}; pg8::StaticOrder S; S.init(M, 2 * FF, G, bx); pg8::EpiSwiglu E{BIG, FF};
        pg8::gemm_phase<pg8::EpiSwiglu, pg8::StaticOrder, true, true>(C.lds, g, S, E); }
    SEAM(2);
    if (IN(3)) for (int rep = 0; rep < NREP(3); ++rep) { pg8::Gemm g{BIG, W1D, M, D, FF}; pg8::StaticOrder S; S.init(M, D, G, bx); pg8::EpiResid E{x, X1, mod + 2 * D, 0.5f};
        pg8::gemm_phase<pg8::EpiResid, pg8::StaticOrder, true, true>(C.lds, g, S, E); }
    SEAM(3);
    if (IN(4)) norm_phase(C, X1, mod, 1, H);
    SEAM(4);
    if (IN(5)) for (int rep = 0; rep < NREP(5); ++rep) { pg8::Gemm g{H, WIN, M, NIN, D}; pg8::StaticOrder S; S.init(M, NIN, G, bx); pg8::EpiStore E{BIG, NIN};
        pg8::gemm_phase<pg8::EpiStore, pg8::StaticOrder, true, true>(C.lds, g, S, E); }
    SEAM(5);
    if (IN(6)) for (int rep = 0; rep < NREP(6); ++rep) prepass_phase(C, BIG, qnw, knw, conv_w, Qn, Kn, Vt, AI);
    SEAM(6);
    if (IN(7)) for (int rep = 0; rep < NREP(7); ++rep) { for (int u = bx; u < BATCH * NHEAD * (SEQ / 256); u += G) { const int uu = BATCH * NHEAD * (SEQ / 256) - 1 - u; attn_unit(C, uu % (BATCH * NHEAD), uu / (BATCH * NHEAD), Qn, Kn, Vt, AI); } }
    SEAM(7);
    if (IN(8)) for (int rep = 0; rep < NREP(8); ++rep) { pg8::Gemm g{AI, WOUT, M, D, D}; pg8::StaticOrder S; S.init(M, D, G, bx); pg8::EpiResid E{X1, out, mod + 5 * D, 1.0f};
        pg8::gemm_phase<pg8::EpiResid, pg8::StaticOrder, true, true>(C.lds, g, S, E); }
    SEAM(8);
    if (IN(9)) norm_phase(C, out, mod, 2, H);
    SEAM(9);
    if (IN(10)) { pg8::Gemm g{H, W2GU, M, 2 * FF, D}; pg8::StaticOrder S; S.init(M, 2 * FF, G, bx); pg8::EpiSwiglu E{BIG, FF};
        pg8::gemm_phase<pg8::EpiSwiglu, pg8::StaticOrder, true, true>(C.lds, g, S, E); }
    SEAM(10);
    if (IN(11)) { pg8::Gemm g{BIG, W2D, M, D, FF}; pg8::StaticOrder S; S.init(M, D, G, bx); pg8::EpiResid E{out, out, mod + 8 * D, 0.5f};
        pg8::gemm_phase<pg8::EpiResid, pg8::StaticOrder, true, true>(C.lds, g, S, E); }
#undef IN
#undef SEAM
}

extern "C" void kernel_launch(void* const* d_in, const int* in_sizes, int n_in, void* d_out, int out_size, void* d_ws, size_t ws_size, hipStream_t stream) {
    static int grid = 0;
    if (grid == 0) {
        if (n_in != 13 || in_sizes[0] != M * D || out_size != M * D || ws_size < WS_END) { fprintf(stderr, "kernel_launch: unexpected shapes (n_in %d, in0 %d, out %d, ws %zu)\n", n_in, n_in > 0 ? in_sizes[0] : -1, out_size, ws_size); grid = -1; return; }
        int dev = 0, cus = 0, per_cu = 0;
        if (hipGetDevice(&dev) != hipSuccess || hipDeviceGetAttribute(&cus, hipDeviceAttributeMultiprocessorCount, dev) != hipSuccess) { grid = -1; return; }
        if (hipFuncSetAttribute((const void*)mk_fwd, hipFuncAttributeMaxDynamicSharedMemorySize, LDS_BYTES) != hipSuccess) { fprintf(stderr, "kernel_launch: hipFuncSetAttribute failed\n"); grid = -1; return; }
        if (hipOccupancyMaxActiveBlocksPerMultiprocessor(&per_cu, (const void*)mk_fwd, NWAVES * 64, LDS_BYTES) != hipSuccess || per_cu < 1) { fprintf(stderr, "kernel_launch: occupancy query says %d\n", per_cu); per_cu = 1; }
        (void)hipGetLastError();
        grid = cus * per_cu;
    }
    if (grid < 0) return;
    (void)hipMemsetAsync((char*)d_ws + WS_MOD, 0, CTL_ZERO_BYTES, stream);
    Args a{};
    for (int i = 0; i < 13; ++i) a.in[i] = (const float*)d_in[i];
    a.out = (float*)d_out; a.ws = (unsigned char*)d_ws;
#if MK_COOP
    a.ph_lo = 0; a.ph_hi = N_PHASES;
    void* kargs[] = {&a};
    hipError_t e = hipLaunchCooperativeKernel((const void*)mk_fwd, dim3(grid), dim3(NWAVES * 64), kargs, LDS_BYTES, stream);
    if (e != hipSuccess) fprintf(stderr, "cooperative launch failed: %s (grid %d)\n", hipGetErrorString(e), grid);
#else
    for (int p = 0; p < N_PHASES; ++p) { a.ph_lo = p; a.ph_hi = p + 1; hipLaunchKernelGGL(mk_fwd, dim3(grid), dim3(NWAVES * 64), LDS_BYTES, stream, a); }
#endif
}
```

```cpp
#include <hip/hip_runtime.h>
#include <hip/hip_cooperative_groups.h>
#include <cstdio>
#include <cstdint>
namespace cg = cooperative_groups;
#ifndef MK_COOP
#define MK_COOP 1
#endif
namespace pg8 {
#define PG8_LAS __attribute__((address_space(3)))
typedef unsigned short bf16_t;
typedef short bf16x8 __attribute__((ext_vector_type(8)));
typedef float f32x4 __attribute__((ext_vector_type(4)));
typedef unsigned u32x4 __attribute__((ext_vector_type(4)));
constexpr int BM = 256, BK = 64, HALF = 128, HTB = HALF * BK * 2  , STAGE_BYTES = 8 * HTB, NXCD = 8, WGM = 8;

__host__ __device__ __forceinline__ int lds_byte(int r, int c) { const int st = (r >> 4) * 2 + (c >> 5), rr = r & 15, cc = c & 31, ob = rr * 64 + cc * 2; return st * 1024 + (ob ^ (((ob >> 9) & 1) << 5)); }
__host__ __device__ __forceinline__ void stage_rc(int b, int& R, int& C) { const int st = b / 1024, sb = b % 1024, swz = sb ^ (((sb >> 9) & 1) << 5); R = (st >> 1) * 16 + swz / 64; C = (st & 1) * 32 + (swz % 64) / 2; }
__host__ __device__ __forceinline__ int perm32(int rho) { const int n = rho >> 4, i = rho & 15; return 8 * (i >> 2) + 4 * n + (i & 3); }

struct Unit { int pm, pn; };
struct Gemm { const bf16_t* A; const bf16_t* Bt; int M, N, K; };

struct StaticOrder {
    int nM, nN, nwg, G, c;
    __host__ __device__ void init(int M, int N, int G_, int c_) { nM = M / BM; nN = N / BM; nwg = nM * nN; G = G_; c = c_; }
    __host__ __device__ bool next(int i, Unit& u) const {
        const long L = (long)i * G + c; if (L >= nwg) return false;
        int wgid = (int)L; { const int q = nwg / NXCD, r = nwg % NXCD, xcd = wgid % NXCD, off = wgid / NXCD; wgid = (xcd < r ? xcd * (q + 1) : r * (q + 1) + (xcd - r) * q) + off; }
        const int nig = WGM * nN, gid = wgid / nig, fm = gid * WGM, gsz = (nM - fm) < WGM ? (nM - fm) : WGM;
        u.pm = fm + ((wgid % nig) % gsz); u.pn = (wgid % nig) / gsz; return true;
    }
    __device__ __forceinline__ void a_ready(const Unit&) const {}
    __device__ __forceinline__ void done(const Unit&) const {}
};

__device__ __forceinline__ unsigned cvt_pk_bf16(float lo, float hi) { unsigned r; asm volatile("v_cvt_pk_bf16_f32 %0, %1, %2" : "=v"(r) : "v"(lo), "v"(hi)); return r; }
typedef float f32x2 __attribute__((ext_vector_type(2)));
template <class Epi, class Sched, bool ALIGN_EPI = false, bool SP2 = false>
__device__ __forceinline__ void gemm_phase(PG8_LAS unsigned char* lds, const Gemm g, const Sched& S, const Epi& E) {
    const int tid = threadIdx.x, wid = __builtin_amdgcn_readfirstlane(tid >> 6), lane = tid & 63, wr = wid >> 2, wc = wid & 3, fr = lane & 15, fq = lane >> 4;
    const int K = g.K, nt = K / BK;
    unsigned voffA[2], voffB[2];
#pragma unroll
    for (int i = 0; i < 2; ++i) { int R, C; stage_rc(tid * 16 + i * 8192, R, C); const int Rb = Epi::PERM ? ((R & ~31) + perm32(R & 31)) : R;
        voffA[i] = (unsigned)(R * K + C) * 2u; voffB[i] = (unsigned)(Rb * K + C) * 2u; }
    const size_t kstep = (size_t)(BK * 2);
    const size_t hstep = (size_t)HALF * K * 2;
    const size_t tstep = 2 * hstep;
    const unsigned ldsw = (unsigned)wid * 1024u;
    const int aoff = lds_byte(wr * 64 + fr, fq * 8), boff = lds_byte(wc * 32 + fr, fq * 8);
#define PG8_SA(b, h) (((b) * 2 + (h)) * HTB)
#define PG8_SB(b, h) ((4 + (b) * 2 + (h)) * HTB)
#define PG8_STAGE(bufoff, gbase, voff) do { _Pragma("unroll") for (int _i = 0; _i < 2; ++_i) \
        __builtin_amdgcn_global_load_lds((const unsigned*)((const char*)(gbase) + (voff)[_i]), (PG8_LAS unsigned*)(lds + (bufoff) + ldsw + _i * 8192), 16, 0, 0); } while (0)
#define PG8_LDA(dst, b, h) do { _Pragma("unroll") for (int m = 0; m < 4; ++m) _Pragma("unroll") for (int k = 0; k < 2; ++k) dst[m][k] = *(const PG8_LAS bf16x8*)(lds + PG8_SA(b, h) + aoff + m * 2048 + k * 1024); } while (0)
#define PG8_LDB(dst, b, h) do { _Pragma("unroll") for (int n = 0; n < 2; ++n) _Pragma("unroll") for (int k = 0; k < 2; ++k) dst[n][k] = *(const PG8_LAS bf16x8*)(lds + PG8_SB(b, h) + boff + n * 2048 + k * 1024); } while (0)
#define PG8_MMA(ai, bj, At, Bt) do { __builtin_amdgcn_s_setprio(1); _Pragma("unroll") for (int m = 0; m < 4; ++m) _Pragma("unroll") for (int n = 0; n < 2; ++n) _Pragma("unroll") for (int k = 0; k < 2; ++k) \
        acc[ai][bj][m][n] = __builtin_amdgcn_mfma_f32_16x16x32_bf16(Bt[n][k], At[m][k], acc[ai][bj][m][n], 0, 0, 0); __builtin_amdgcn_s_setprio(0); } while (0)
#define PG8_WAIT_V(n) asm volatile("s_waitcnt vmcnt(" #n ")" ::: "memory")
#define PG8_WAIT_L(n) asm volatile("s_waitcnt lgkmcnt(" #n ")" ::: "memory")
#define PG8_BAR __builtin_amdgcn_s_barrier()
#define PG8_SCHED __builtin_amdgcn_sched_barrier(0)
    Unit cur, nxt; int ui = 0;
    if (!S.next(0, cur)) return;
    f32x4 acc[2][2][4][2];
#pragma unroll
    for (int a = 0; a < 2; ++a)
#pragma unroll
        for (int b = 0; b < 2; ++b)
#pragma unroll
            for (int m = 0; m < 4; ++m)
#pragma unroll
                for (int n = 0; n < 2; ++n) acc[a][b][m][n] = (f32x4){0.f, 0.f, 0.f, 0.f};
    bf16x8 At[4][2], B0[2][2], B1[2][2];
    const char* cA = (const char*)g.A + (size_t)cur.pm * tstep; const char* cB = (const char*)g.Bt + (size_t)cur.pn * tstep;
    S.a_ready(cur);
    if constexpr (SP2) {
        PG8_STAGE(PG8_SB(0, 0), cB, voffB); PG8_STAGE(PG8_SB(0, 1), cB + hstep, voffB); PG8_STAGE(PG8_SA(0, 0), cA, voffA); PG8_STAGE(PG8_SA(0, 1), cA + hstep, voffA);
        if (wr == 1) PG8_BAR;
        PG8_WAIT_V(2); PG8_BAR;
        PG8_STAGE(PG8_SB(1, 0), cB + kstep, voffB); PG8_STAGE(PG8_SA(1, 0), cA + kstep, voffA); PG8_STAGE(PG8_SB(1, 1), cB + hstep + kstep, voffB);
        PG8_WAIT_V(6); PG8_BAR;
    } else {
        PG8_STAGE(PG8_SB(0, 0), cB, voffB); PG8_STAGE(PG8_SA(0, 0), cA, voffA); PG8_STAGE(PG8_SB(0, 1), cB + hstep, voffB); PG8_STAGE(PG8_SA(0, 1), cA + hstep, voffA);
        if (wr == 1) PG8_BAR;
        PG8_WAIT_V(4); PG8_BAR;
        PG8_STAGE(PG8_SB(1, 0), cB + kstep, voffB); PG8_STAGE(PG8_SA(1, 0), cA + kstep, voffA); PG8_STAGE(PG8_SB(1, 1), cB + hstep + kstep, voffB);
        PG8_WAIT_V(6); PG8_BAR;
    }
    for (;;) {
        const bool has_next = S.next(ui + 1, nxt);
        const char* nA = has_next ? (const char*)g.A + (size_t)nxt.pm * tstep : cA; const char* nB = has_next ? (const char*)g.Bt + (size_t)nxt.pn * tstep : cB;
        for (int t = 0; t < nt; t += 2) {
            const bool last = (t == nt - 2);
            const char* a1 = cA + (size_t)(t + 1) * kstep;
            const char* a2 = last ? nA : cA + (size_t)(t + 2) * kstep; const char* b2 = last ? nB : cB + (size_t)(t + 2) * kstep;
            const char* a3 = a2 + kstep; const char* b3 = b2 + kstep;
            if (last && has_next) S.a_ready(nxt);
            if constexpr (SP2) {
            PG8_LDB(B0, 0, 0); PG8_LDB(B1, 0, 1); PG8_SCHED; PG8_LDA(At, 0, 0); PG8_STAGE(PG8_SA(1, 1), a1 + hstep, voffA);
            PG8_WAIT_V(8); PG8_WAIT_L(0); PG8_BAR; PG8_MMA(0, 0, At, B0); PG8_MMA(0, 1, At, B1); PG8_BAR; PG8_SCHED;
            PG8_LDA(At, 0, 1); PG8_STAGE(PG8_SB(0, 0), b2, voffB); PG8_STAGE(PG8_SB(0, 1), b2 + hstep, voffB); PG8_STAGE(PG8_SA(0, 0), a2, voffA);
            PG8_WAIT_V(8); PG8_WAIT_L(0); PG8_BAR; PG8_MMA(1, 0, At, B0); PG8_MMA(1, 1, At, B1); PG8_BAR; PG8_SCHED;
            PG8_LDB(B0, 1, 0); PG8_LDB(B1, 1, 1); PG8_SCHED; PG8_LDA(At, 1, 0); PG8_STAGE(PG8_SA(0, 1), a2 + hstep, voffA);
            PG8_WAIT_V(8); PG8_WAIT_L(0); PG8_BAR; PG8_MMA(0, 0, At, B0); PG8_MMA(0, 1, At, B1); PG8_BAR; PG8_SCHED;
            PG8_LDA(At, 1, 1); PG8_STAGE(PG8_SB(1, 0), b3, voffB); PG8_STAGE(PG8_SB(1, 1), b3 + hstep, voffB); PG8_STAGE(PG8_SA(1, 0), a3, voffA);
            PG8_WAIT_V(8); PG8_WAIT_L(0); PG8_BAR; PG8_MMA(1, 0, At, B0); PG8_MMA(1, 1, At, B1); PG8_BAR; PG8_SCHED;
            } else {
            PG8_LDB(B0, 0, 0); PG8_SCHED; PG8_LDA(At, 0, 0); PG8_STAGE(PG8_SA(1, 1), a1 + hstep, voffA);
            PG8_WAIT_L(8); PG8_BAR; PG8_WAIT_L(0); PG8_MMA(0, 0, At, B0); PG8_BAR; PG8_SCHED;
            PG8_LDB(B1, 0, 1); PG8_STAGE(PG8_SB(0, 0), b2, voffB);
            PG8_BAR; PG8_WAIT_L(0); PG8_MMA(0, 1, At, B1); PG8_BAR;
            PG8_LDA(At, 0, 1); PG8_STAGE(PG8_SA(0, 0), a2, voffA);
            PG8_BAR; PG8_WAIT_L(0); PG8_MMA(1, 0, At, B0); PG8_BAR; PG8_SCHED;
            PG8_STAGE(PG8_SB(0, 1), b2 + hstep, voffB);
            PG8_WAIT_V(6); PG8_BAR; PG8_MMA(1, 1, At, B1); PG8_BAR;
            PG8_LDB(B0, 1, 0); PG8_SCHED; PG8_LDA(At, 1, 0); PG8_STAGE(PG8_SA(0, 1), a2 + hstep, voffA);
            PG8_WAIT_L(8); PG8_BAR; PG8_WAIT_L(0); PG8_MMA(0, 0, At, B0); PG8_BAR; PG8_SCHED;
            PG8_LDB(B1, 1, 1); PG8_STAGE(PG8_SB(1, 0), b3, voffB);
            PG8_BAR; PG8_WAIT_L(0); PG8_MMA(0, 1, At, B1); PG8_BAR;
            PG8_LDA(At, 1, 1); PG8_STAGE(PG8_SA(1, 0), a3, voffA);
            PG8_BAR; PG8_WAIT_L(0); PG8_MMA(1, 0, At, B0); PG8_BAR; PG8_SCHED;
            PG8_STAGE(PG8_SB(1, 1), b3 + hstep, voffB);
            PG8_WAIT_V(6); PG8_BAR; PG8_MMA(1, 1, At, B1); PG8_BAR;
            }
        }
        if constexpr (ALIGN_EPI) { if (wr == 0) PG8_BAR; }
        if constexpr (!Epi::AFTER_DRAIN) { E(acc, cur, wr, wc, fr, fq); S.done(cur); }
        if (!has_next) break;
#pragma unroll
        for (int a = 0; a < 2; ++a)
#pragma unroll
            for (int b = 0; b < 2; ++b)
#pragma unroll
                for (int m = 0; m < 4; ++m)
#pragma unroll
                    for (int n = 0; n < 2; ++n) acc[a][b][m][n] = (f32x4){0.f, 0.f, 0.f, 0.f};
        cur = nxt; cA = nA; cB = nB; ++ui;
        if constexpr (ALIGN_EPI) { if (wr == 1) PG8_BAR; }
    }
    PG8_WAIT_V(0);
    if constexpr (!ALIGN_EPI) { if (wr == 0) PG8_BAR; }
    PG8_BAR;
    if constexpr (Epi::AFTER_DRAIN) { E.fused(acc, cur, wr, wc, fr, fq, lds, wid, lane); S.done(cur); }
#undef PG8_SA
#undef PG8_SB
#undef PG8_STAGE
#undef PG8_LDA
#undef PG8_LDB
#undef PG8_MMA
#undef PG8_WAIT_V
#undef PG8_WAIT_L
#undef PG8_BAR
#undef PG8_SCHED
}
}

constexpr int BATCH = 2, SEQ = 4096, D = 2048, M = BATCH * SEQ, FF = 5632, NIN = 6144, NHEAD = 8, HD = 128, NMOD = 9;
constexpr int NWAVES = 8;
constexpr float EPS = 1e-6f;
constexpr float LOG2E = 1.4426950408889634f;
constexpr float QSCALE = 0.08838834764831845f * LOG2E;
constexpr size_t MiB = 1u << 20;
constexpr size_t WS_MOD = 0, MOD_BYTES = (size_t)BATCH * NMOD * D * 4;
constexpr size_t WS_W1GU = 1 * MiB, WS_W1D = 45 * MiB, WS_WIN = 67 * MiB, WS_WOUT = 91 * MiB, WS_W2GU = 99 * MiB, WS_W2D = 143 * MiB;
constexpr size_t WS_H = 165 * MiB, WS_BIG = 197 * MiB, WS_X1 = 293 * MiB, WS_AI = 357 * MiB, WS_QN = 389 * MiB, WS_KN = 405 * MiB, WS_VT = 421 * MiB, WS_END = 437 * MiB;
constexpr int LDS_BYTES = 147456, LDSCTL_OFF = 131072;
constexpr size_t WS_CTL = 256 * 1024, CTL_ZERO_BYTES = 512 * 1024;
constexpr int N_PHASES = 12;

#define LAS __attribute__((address_space(3)))
typedef unsigned short bf16_t;
typedef float f32x4 __attribute__((ext_vector_type(4)));
typedef float f32x16 __attribute__((ext_vector_type(16)));
typedef unsigned u32x4 __attribute__((ext_vector_type(4)));
typedef short bf16x8 __attribute__((ext_vector_type(8)));
typedef float f32x2_t __attribute__((ext_vector_type(2)));
typedef __bf16 bf16x2_t __attribute__((ext_vector_type(2)));
#define LDS_WAIT() asm volatile("s_waitcnt lgkmcnt(0)" ::: "memory")
__device__ __forceinline__ unsigned pk2(float lo, float hi) { f32x2_t v = {lo, hi}; bf16x2_t b = __builtin_convertvector(v, bf16x2_t); return __builtin_bit_cast(unsigned, b); }
__device__ __forceinline__ float bflo(unsigned u) { return __uint_as_float(u << 16); }
__device__ __forceinline__ float bfhi(unsigned u) { return __uint_as_float(u & 0xffff0000u); }
__device__ __forceinline__ float wave_sum(float v) {
#pragma unroll
    for (int o = 1; o < 64; o <<= 1) v += __shfl_xor(v, o);
    return v;
}
__device__ __forceinline__ float silu_f(float v) { return v * __builtin_amdgcn_rcpf(1.0f + __builtin_amdgcn_exp2f(-v * LOG2E)); }

namespace pg8 {
struct EpiStore {
    static constexpr bool PERM = true, AFTER_DRAIN = false;
    bf16_t* O; int ldc;
    __device__ __forceinline__ void operator()(const f32x4 (&acc)[2][2][4][2], const Unit& u, int wr, int wc, int fr, int fq) const {
        const int row0 = u.pm * BM + wr * 64 + fr, col0 = u.pn * BM + wc * 32 + 8 * fq;
#pragma unroll
        for (int ai = 0; ai < 2; ++ai)
#pragma unroll
            for (int m = 0; m < 4; ++m) { bf16_t* rowp = O + (size_t)(row0 + ai * HALF + m * 16) * ldc + col0;
#pragma unroll
                for (int bj = 0; bj < 2; ++bj) { const f32x4 v0 = acc[ai][bj][m][0], v1 = acc[ai][bj][m][1];
                    u32x4 w; w.x = ::pk2(v0[0], v0[1]); w.y = ::pk2(v0[2], v0[3]); w.z = ::pk2(v1[0], v1[1]); w.w = ::pk2(v1[2], v1[3]);
                    *(u32x4*)(rowp + bj * HALF) = w; } }
    }
};
struct EpiSwiglu {
    static constexpr bool PERM = true, AFTER_DRAIN = false;
    bf16_t* O; int ldc;
    __device__ __forceinline__ void operator()(const f32x4 (&acc)[2][2][4][2], const Unit& u, int wr, int wc, int fr, int fq) const {
        const int row0 = u.pm * BM + wr * 64 + fr, col0 = u.pn * HALF + wc * 32 + 8 * fq;
#pragma unroll
        for (int ai = 0; ai < 2; ++ai)
#pragma unroll
            for (int m = 0; m < 4; ++m) { bf16_t* rowp = O + (size_t)(row0 + ai * HALF + m * 16) * ldc + col0;
                float r[8];
#pragma unroll
                for (int n = 0; n < 2; ++n)
#pragma unroll
                    for (int e = 0; e < 4; ++e) { const float g = acc[ai][0][m][n][e], up = acc[ai][1][m][n][e]; r[4 * n + e] = ::silu_f(g) * up; }
                u32x4 w; w.x = ::pk2(r[0], r[1]); w.y = ::pk2(r[2], r[3]); w.z = ::pk2(r[4], r[5]); w.w = ::pk2(r[6], r[7]);
                *(u32x4*)rowp = w; }
    }
};
struct EpiResid {
    static constexpr bool PERM = false, AFTER_DRAIN = false;
    const float* base; float* out; const float* gate; float scale;
    __device__ __forceinline__ void operator()(const f32x4 (&acc)[2][2][4][2], const Unit& u, int wr, int wc, int fr, int fq) const {
        const int row0 = u.pm * BM + wr * 64 + fr, col0 = u.pn * BM + wc * 32 + 4 * fq;
        const float* gp = gate + (size_t)((u.pm * BM) / SEQ) * (NMOD * D) + col0;
        f32x4 gv[2][2];
#pragma unroll
        for (int bj = 0; bj < 2; ++bj)
#pragma unroll
            for (int n = 0; n < 2; ++n) gv[bj][n] = *(const f32x4*)(gp + bj * HALF + n * 16) * scale;
#pragma unroll
        for (int ai = 0; ai < 2; ++ai)
#pragma unroll
            for (int m = 0; m < 4; ++m) { const size_t off = (size_t)(row0 + ai * HALF + m * 16) * D + col0;
#pragma unroll
                for (int bj = 0; bj < 2; ++bj)
#pragma unroll
                    for (int n = 0; n < 2; ++n) { const f32x4 bs = *(const f32x4*)(base + off + bj * HALF + n * 16);
                        *(f32x4*)(out + off + bj * HALF + n * 16) = bs + gv[bj][n] * acc[ai][bj][m][n]; } }
    }
};
}

struct Ctx {
    LAS unsigned char* lds; int tid, lane, wave, gw, NGW;
};

__device__ __forceinline__ void tr_item_f32(const float* __restrict__ src, int N, int k0, int n0, bf16_t* __restrict__ dst, size_t dpitch, size_t drow0, LAS unsigned* T, int lane) {
    const int nq = lane & 15, kr = lane >> 4;
    const float* s = src + (size_t)(k0 + 2 * kr) * N + n0 + 4 * nq;
    f32x4 a[8], b[8];
#pragma unroll
    for (int it = 0; it < 8; ++it) { a[it] = __builtin_nontemporal_load((const f32x4*)(s + (size_t)(8 * it) * N)); b[it] = __builtin_nontemporal_load((const f32x4*)(s + (size_t)(8 * it + 1) * N)); }
#pragma unroll
    for (int it = 0; it < 8; ++it) { const int kp = it * 4 + kr;
#pragma unroll
        for (int j = 0; j < 4; ++j) T[(4 * nq + j) * 33 + kp] = pk2(a[it][j], b[it][j]); }
    LDS_WAIT();
    const int c = lane & 7, nn = lane >> 3;
#pragma unroll
    for (int jj = 0; jj < 8; ++jj) { const int n = nn + 8 * jj; const LAS unsigned* p = T + n * 33 + 4 * c;
        u32x4 o; o.x = p[0]; o.y = p[1]; o.z = p[2]; o.w = p[3];
        *(u32x4*)(dst + (drow0 + n) * dpitch + k0 + 8 * c) = o; }
    LDS_WAIT();
}
__device__ __forceinline__ void tr_item_bf16(const bf16_t* __restrict__ src, size_t spitch, bf16_t* __restrict__ dst, size_t dpitch, LAS unsigned* T, int lane) {
    const int dq = lane & 7, kr = lane >> 3;
    const bf16_t* s = src + (size_t)(2 * kr) * spitch + 8 * dq;
    u32x4 a[4], b[4];
#pragma unroll
    for (int it = 0; it < 4; ++it) { a[it] = *(const u32x4*)(s + (size_t)(16 * it) * spitch); b[it] = *(const u32x4*)(s + (size_t)(16 * it + 1) * spitch); }
#pragma unroll
    for (int it = 0; it < 4; ++it) { const int kp = it * 8 + kr;
#pragma unroll
        for (int j = 0; j < 4; ++j) { const unsigned x = a[it][j], y = b[it][j];
            T[(8 * dq + 2 * j) * 33 + kp] = (x & 0xffffu) | (y << 16);
            T[(8 * dq + 2 * j + 1) * 33 + kp] = (x >> 16) | (y & 0xffff0000u); } }
    LDS_WAIT();
    const int c = lane & 7, nn = lane >> 3;
#pragma unroll
    for (int jj = 0; jj < 8; ++jj) { const int n = nn + 8 * jj; const LAS unsigned* p = T + n * 33 + 4 * c;
        u32x4 o; o.x = p[0]; o.y = p[1]; o.z = p[2]; o.w = p[3];
        *(u32x4*)(dst + (size_t)n * dpitch + 8 * c) = o; }
    LDS_WAIT();
}

__device__ __forceinline__ void tr_weight_item(const float* W, int K, int N, bf16_t* WT, bool gu, int item, LAS unsigned* T, int lane) {
    const int nblk = N / 64, kb = item / nblk, nb = item % nblk, n0 = nb * 64;
    size_t drow0 = n0;
    if (gu) { const int half = (n0 >= FF) ? 1 : 0, j = n0 - half * FF; drow0 = (size_t)(j >> 7) * 256 + half * 128 + (j & 127); }
    tr_item_f32(W, N, kb * 64, n0, WT, (size_t)K, drow0, T, lane);
}

__device__ __forceinline__ void adaln_item(const float* __restrict__ c, const float* __restrict__ w_ada, const float* __restrict__ b_ada, float* mod, int item, int lane) {
    constexpr int NC = NMOD * D;
    const int cb = item % (NC / 256), kc = item / (NC / 256), k0 = kc * 32, n0 = cb * 256 + 4 * lane;
    float s0 = 0.f, s1 = 0.f;
    if (lane < 32) { s0 = silu_f(c[k0 + lane]); s1 = silu_f(c[D + k0 + lane]); }
    f32x4 a0 = {0.f, 0.f, 0.f, 0.f}, a1 = {0.f, 0.f, 0.f, 0.f};
    const float* wp = w_ada + (size_t)k0 * NC + n0;
#pragma unroll 8
    for (int kk = 0; kk < 32; ++kk) { const f32x4 w = __builtin_nontemporal_load((const f32x4*)(wp + (size_t)kk * NC)); const float c0 = __shfl(s0, kk), c1 = __shfl(s1, kk); a0 += w * c0; a1 += w * c1; }
    if (kc == 0) { const f32x4 bv = *(const f32x4*)(b_ada + n0); a0 += bv; a1 += bv; }
#pragma unroll
    for (int e = 0; e < 4; ++e) { unsafeAtomicAdd(mod + n0 + e, a0[e]); unsafeAtomicAdd(mod + NC + n0 + e, a1[e]); }
}

__device__ __forceinline__ void norm_phase(const Ctx& C, const float* __restrict__ X, const float* __restrict__ mod, int mi, bf16_t* __restrict__ H) {
    for (int m = C.gw; m < M; m += C.NGW) {
        const float* xr = X + (size_t)m * D + 8 * C.lane;
        f32x4 v[4][2]; float ss = 0.f;
#pragma unroll
        for (int j = 0; j < 4; ++j) { v[j][0] = *(const f32x4*)(xr + 512 * j); v[j][1] = *(const f32x4*)(xr + 512 * j + 4);
            ss += (v[j][0][0] * v[j][0][0] + v[j][0][1] * v[j][0][1]) + (v[j][0][2] * v[j][0][2] + v[j][0][3] * v[j][0][3]);
            ss += (v[j][1][0] * v[j][1][0] + v[j][1][1] * v[j][1][1]) + (v[j][1][2] * v[j][1][2] + v[j][1][3] * v[j][1][3]); }
        const float rstd = __builtin_amdgcn_rsqf(wave_sum(ss) * (1.0f / D) + EPS);
        const float* sh = mod + (size_t)(m / SEQ) * (NMOD * D) + (size_t)(3 * mi) * D + 8 * C.lane; const float* sc = sh + D;
        bf16_t* hr = H + (size_t)m * D + 8 * C.lane;
#pragma unroll
        for (int j = 0; j < 4; ++j) { f32x4 r0 = v[j][0] * rstd * (*(const f32x4*)(sc + 512 * j) + 1.0f) + *(const f32x4*)(sh + 512 * j);
            f32x4 r1 = v[j][1] * rstd * (*(const f32x4*)(sc + 512 * j + 4) + 1.0f) + *(const f32x4*)(sh + 512 * j + 4);
            u32x4 w; w.x = pk2(r0[0], r0[1]); w.y = pk2(r0[2], r0[3]); w.z = pk2(r1[0], r1[1]); w.w = pk2(r1[2], r1[3]);
            *(u32x4*)(hr + 512 * j) = w; }
    }
}

__device__ __forceinline__ void prepass_phase(const Ctx& C, const bf16_t* __restrict__ PROJ, const float* __restrict__ qw, const float* __restrict__ kw, const float* __restrict__ convw,
                                              bf16_t* __restrict__ Qn, bf16_t* __restrict__ Kn, bf16_t* __restrict__ Vt, bf16_t* __restrict__ AI) {
    LAS unsigned* T = (LAS unsigned*)(C.lds + C.wave * 16384);
    constexpr int I_ROW = M, I_VT = BATCH * NHEAD * (SEQ / 64) * 2, I_CONV = BATCH * (SEQ / 8) * 2;
    for (int it = C.gw; it < I_ROW + I_VT + I_CONV; it += C.NGW) {
        if (it < I_ROW) {
            const int m = it, b = m / SEQ, s = m % SEQ, lane = C.lane;
            const bf16_t* p = PROJ + (size_t)m * NIN + 32 * lane;
            u32x4 x[4]; float f[32]; float ss = 0.f;
#pragma unroll
            for (int j = 0; j < 4; ++j) x[j] = *(const u32x4*)(p + 8 * j);
#pragma unroll
            for (int j = 0; j < 4; ++j)
#pragma unroll
                for (int e = 0; e < 4; ++e) { f[8 * j + 2 * e] = bflo(x[j][e]); f[8 * j + 2 * e + 1] = bfhi(x[j][e]); }
#pragma unroll
            for (int e = 0; e < 32; ++e) ss += f[e] * f[e];
            ss += __shfl_xor(ss, 1); ss += __shfl_xor(ss, 2);
            const int head = lane >> 2, d0 = (lane & 3) * 32; const bool isq = head < 8;
            const float rs = __builtin_amdgcn_rsqf(ss * (1.0f / HD) + EPS) * (isq ? QSCALE : 1.0f);
            const float* g = (isq ? qw : kw) + d0;
            bf16_t* o = (isq ? Qn : Kn) + (((size_t)b * NHEAD + (head & 7)) * SEQ + s) * HD + d0;
#pragma unroll
            for (int j = 0; j < 4; ++j) { const f32x4 g0 = *(const f32x4*)(g + 8 * j), g1 = *(const f32x4*)(g + 8 * j + 4);
                u32x4 w; w.x = pk2(f[8 * j] * rs * g0[0], f[8 * j + 1] * rs * g0[1]); w.y = pk2(f[8 * j + 2] * rs * g0[2], f[8 * j + 3] * rs * g0[3]);
                w.z = pk2(f[8 * j + 4] * rs * g1[0], f[8 * j + 5] * rs * g1[1]); w.w = pk2(f[8 * j + 6] * rs * g1[2], f[8 * j + 7] * rs * g1[3]);
                *(u32x4*)(o + 8 * j) = w; }
        } else if (it < I_ROW + I_VT) {
            const int r = it - I_ROW, dh = r & 1, sb = (r >> 1) % (SEQ / 64), bh = (r >> 1) / (SEQ / 64), b = bh / NHEAD, hh = bh % NHEAD;
            const bf16_t* src = PROJ + ((size_t)b * SEQ + sb * 64) * NIN + 2048 + hh * HD + dh * 64;
            bf16_t* dst = Vt + ((size_t)bh * HD + dh * 64) * SEQ + sb * 64;
            tr_item_bf16(src, NIN, dst, SEQ, T, C.lane);
        } else {
            const int r = it - I_ROW - I_VT, half = r & 1, tb = (r >> 1) % (SEQ / 8), b = (r >> 1) / (SEQ / 8), t0 = tb * 8, ch = half * 512 + 8 * C.lane;
            float w0[8], w1[8], w2[8];
#pragma unroll
            for (int e = 0; e < 8; ++e) { w0[e] = convw[ch + e]; w1[e] = convw[1024 + ch + e]; w2[e] = convw[2048 + ch + e]; }
            const bf16_t* p = PROJ + ((size_t)b * SEQ + t0) * NIN + ch;
            u32x4 gb[8], gc[10], uu[10];
#pragma unroll
            for (int i = 0; i < 10; ++i) { if (t0 + i - 2 >= 0) { gc[i] = *(const u32x4*)(p + (ptrdiff_t)(i - 2) * NIN + 4096); uu[i] = *(const u32x4*)(p + (ptrdiff_t)(i - 2) * NIN + 5120); }
                else { gc[i] = (u32x4){0u, 0u, 0u, 0u}; uu[i] = (u32x4){0u, 0u, 0u, 0u}; } }
#pragma unroll
            for (int i = 0; i < 8; ++i) gb[i] = *(const u32x4*)(p + (size_t)i * NIN + 3072);
            float c1[8], c2[8];
#pragma unroll
            for (int i = 0; i < 10; ++i) { float cu[8];
#pragma unroll
                for (int e = 0; e < 4; ++e) { cu[2 * e] = bflo(gc[i][e]) * bflo(uu[i][e]); cu[2 * e + 1] = bfhi(gc[i][e]) * bfhi(uu[i][e]); }
                if (i >= 2) { float y[8];
#pragma unroll
                    for (int e = 0; e < 4; ++e) { y[2 * e] = bflo(gb[i - 2][e]) * (w0[2 * e] * c2[2 * e] + w1[2 * e] * c1[2 * e] + w2[2 * e] * cu[2 * e]);
                        y[2 * e + 1] = bfhi(gb[i - 2][e]) * (w0[2 * e + 1] * c2[2 * e + 1] + w1[2 * e + 1] * c1[2 * e + 1] + w2[2 * e + 1] * cu[2 * e + 1]); }
                    u32x4 w; w.x = pk2(y[0], y[1]); w.y = pk2(y[2], y[3]); w.z = pk2(y[4], y[5]); w.w = pk2(y[6], y[7]);
                    *(u32x4*)(AI + ((size_t)b * SEQ + t0 + i - 2) * D + 1024 + ch) = w; }
#pragma unroll
                for (int e = 0; e < 8; ++e) { c2[e] = (i >= 1) ? c1[e] : 0.f; c1[e] = cu[e]; } }
        }
    }
}

#define MFMA32(a, b, c) __builtin_amdgcn_mfma_f32_32x32x16_bf16((a), (b), (c), 0, 0, 0)
constexpr int KPITCH = 272, VPITCH = 144, LDS_KT = 0, LDS_VT = 64 * KPITCH, LDS_FLAG = LDS_VT + 128 * VPITCH;
__device__ __forceinline__ void attn_unit(const Ctx& C, int bh, int qb, const bf16_t* __restrict__ Qn, const bf16_t* __restrict__ Kn, const bf16_t* __restrict__ Vt, bf16_t* __restrict__ AI) {
    const int lane = C.lane, r = lane & 31, h = lane >> 5, tid = C.tid;
    const int t0 = qb * 256 + C.wave * 32, t = t0 + r;
    bf16x8 qf[8];
    { const bf16_t* Qw = Qn + ((size_t)bh * SEQ + t) * HD + 8 * h;
#pragma unroll
      for (int c = 0; c < 8; ++c) qf[c] = *(const bf16x8*)(Qw + 16 * c); }
    f32x16 o[4];
#pragma unroll
    for (int db = 0; db < 4; ++db)
#pragma unroll
        for (int i = 0; i < 16; ++i) o[db][i] = 0.f;
    float R = 0.f;
    const int jlast = qb * 4 + 3, jw = t0 >> 6;
    const int ii = (r & 3) + 4 * (r >> 3), kvm = 16 * (ii >> 3) + 8 * ((r >> 2) & 1) + (ii & 7);
    const LAS unsigned char* Kl = C.lds + LDS_KT + kvm * KPITCH + h * 16;
    const LAS unsigned char* Vl = C.lds + LDS_VT + r * VPITCH + h * 16;
    const bf16_t* Kg = Kn + (size_t)bh * SEQ * HD; const bf16_t* Vg = Vt + (size_t)bh * HD * SEQ;
    u32x4 kreg[2], vreg[2];
#define ATT_PREFETCH(j) do { _Pragma("unroll") for (int i_ = 0; i_ < 2; ++i_) { const int p_ = tid + 512 * i_; \
        kreg[i_] = *(const u32x4*)(Kg + (size_t)(j) * 64 * HD + (size_t)p_ * 8); \
        vreg[i_] = *(const u32x4*)(Vg + (size_t)(p_ >> 3) * SEQ + (j) * 64 + (p_ & 7) * 8); } } while (0)
    ATT_PREFETCH(jlast);
    LAS unsigned* wflag = (LAS unsigned*)(C.lds + LDS_FLAG);
    if (lane == 0) wflag[C.wave] = 0u;
    for (int j = jlast; j >= 0; --j) {
        __syncthreads();
        { const u32x4 f0 = *(const LAS u32x4*)wflag, f1 = *(const LAS u32x4*)(wflag + 4); if ((f0.x & f0.y & f0.z & f0.w & f1.x & f1.y & f1.z & f1.w) != 0u) break; }
#pragma unroll
        for (int i_ = 0; i_ < 2; ++i_) { const int p_ = tid + 512 * i_;
            *(LAS u32x4*)(C.lds + LDS_KT + (p_ >> 4) * KPITCH + (p_ & 15) * 16) = kreg[i_];
            *(LAS u32x4*)(C.lds + LDS_VT + (p_ >> 3) * VPITCH + (p_ & 7) * 16) = vreg[i_]; }
        __syncthreads();
        if (j > 0) ATT_PREFETCH(j - 1);
        if (j <= jw) {
            f32x16 p0, p1;
#pragma unroll
            for (int i = 0; i < 16; ++i) { p0[i] = 0.f; p1[i] = 0.f; }
#pragma unroll
            for (int c = 0; c < 8; ++c) { const bf16x8 k0 = *(const LAS bf16x8*)(Kl + c * 32), k1 = *(const LAS bf16x8*)(Kl + 32 * KPITCH + c * 32);
                p0 = MFMA32(k0, qf[c], p0); p1 = MFMA32(k1, qf[c], p1); }
            const bool diag = (j == jw);
            const int kvb = 64 * j + 8 * h;
            float lf0[16], lf1[16];
#pragma unroll
            for (int i = 0; i < 16; ++i) {
                const int kv = kvb + 16 * (i >> 3) + (i & 7);
                { const float z = p0[i]; float l = -(fmaxf(z, 0.f) + __builtin_amdgcn_logf(1.0f + __builtin_amdgcn_exp2f(-fabsf(z)))); if (diag && kv >= t) l = 0.f; lf0[i] = l; }
                { const float z = p1[i]; float l = -(fmaxf(z, 0.f) + __builtin_amdgcn_logf(1.0f + __builtin_amdgcn_exp2f(-fabsf(z)))); if (diag && kv + 32 >= t) l = 0.f; lf1[i] = l; }
            }
            float gs[4], og[4];
            gs[0] = ((lf0[0] + lf0[1]) + (lf0[2] + lf0[3])) + ((lf0[4] + lf0[5]) + (lf0[6] + lf0[7]));
            gs[1] = ((lf0[8] + lf0[9]) + (lf0[10] + lf0[11])) + ((lf0[12] + lf0[13]) + (lf0[14] + lf0[15]));
            gs[2] = ((lf1[0] + lf1[1]) + (lf1[2] + lf1[3])) + ((lf1[4] + lf1[5]) + (lf1[6] + lf1[7]));
            gs[3] = ((lf1[8] + lf1[9]) + (lf1[10] + lf1[11])) + ((lf1[12] + lf1[13]) + (lf1[14] + lf1[15]));
#pragma unroll
            for (int g = 0; g < 4; ++g) og[g] = __shfl_xor(gs[g], 32);
            float off[4]; float run = R;
#pragma unroll
            for (int g = 3; g >= 0; --g) { off[g] = run + (h == 0 ? og[g] : 0.f); run += gs[g] + og[g]; }
            R = run;
            { const bool dead = __builtin_amdgcn_ballot_w64(!(R < -160.0f)) == 0ull; if (lane == 0) wflag[C.wave] = dead ? 1u : 0u; }
#pragma unroll
            for (int g = 0; g < 2; ++g) { float c = off[g];
#pragma unroll
                for (int e = 7; e >= 0; --e) { const int i = 8 * g + e; c += lf0[i]; const int kv = kvb + 16 * g + e; float a = __builtin_amdgcn_exp2f(p0[i] + c); if (diag && kv >= t) a = 0.f; p0[i] = a; } }
#pragma unroll
            for (int g = 0; g < 2; ++g) { float c = off[2 + g];
#pragma unroll
                for (int e = 7; e >= 0; --e) { const int i = 8 * g + e; c += lf1[i]; const int kv = kvb + 32 + 16 * g + e; float a = __builtin_amdgcn_exp2f(p1[i] + c); if (diag && kv >= t) a = 0.f; p1[i] = a; } }
            bf16x8 pa[4];
            { u32x4 w;
              w.x = pk2(p0[0], p0[1]); w.y = pk2(p0[2], p0[3]); w.z = pk2(p0[4], p0[5]); w.w = pk2(p0[6], p0[7]); pa[0] = __builtin_bit_cast(bf16x8, w);
              w.x = pk2(p0[8], p0[9]); w.y = pk2(p0[10], p0[11]); w.z = pk2(p0[12], p0[13]); w.w = pk2(p0[14], p0[15]); pa[1] = __builtin_bit_cast(bf16x8, w);
              w.x = pk2(p1[0], p1[1]); w.y = pk2(p1[2], p1[3]); w.z = pk2(p1[4], p1[5]); w.w = pk2(p1[6], p1[7]); pa[2] = __builtin_bit_cast(bf16x8, w);
              w.x = pk2(p1[8], p1[9]); w.y = pk2(p1[10], p1[11]); w.z = pk2(p1[12], p1[13]); w.w = pk2(p1[14], p1[15]); pa[3] = __builtin_bit_cast(bf16x8, w); }
#pragma unroll
            for (int db = 0; db < 4; ++db)
#pragma unroll
                for (int s = 0; s < 4; ++s) { const bf16x8 vf = *(const LAS bf16x8*)(Vl + db * 32 * VPITCH + s * 32); o[db] = MFMA32(pa[s], vf, o[db]); }
        }
    }
#undef ATT_PREFETCH
    const int b = bh / NHEAD, hh = bh % NHEAD;
#pragma unroll
    for (int i = 0; i < 16; ++i) { const int q = (i & 3) + 8 * (i >> 2) + 4 * h; bf16_t* op = AI + ((size_t)b * SEQ + t0 + q) * D + hh * HD + r;
#pragma unroll
        for (int db = 0; db < 4; ++db) op[32 * db] = (bf16_t)(pk2(o[db][i], 0.f) & 0xffffu); }
    __syncthreads();
}

#define XB_TMO      128
#define XB_XCNT(j)  (256  + 64 * (j))
#define XB_XSUB(j)  (1280 + 64 * (j))
#define XB_XGEN(j)  (2304 + 64 * (j))
#define XB_TOP      3328
#define XB_TOPGEN   3392
#define XCD_BAR_WORDS 3456
#define XB_SPIN_CAP (1u << 18)

__device__ __forceinline__ unsigned xb_ld(unsigned* p)              { return __hip_atomic_load(p, __ATOMIC_RELAXED, __HIP_MEMORY_SCOPE_AGENT); }
__device__ __forceinline__ unsigned xb_add(unsigned* p, unsigned v) { return __hip_atomic_fetch_add(p, v, __ATOMIC_RELAXED, __HIP_MEMORY_SCOPE_AGENT); }
__device__ __forceinline__ unsigned xb_xcc_id() { return (unsigned)__builtin_amdgcn_s_getreg((3 << 11) | 20) & 0xFu; }
#define XB_SPIN(cond, bar) do { unsigned _sp = 0; while (cond) { __builtin_amdgcn_s_sleep(1); \
    if ((++_sp & 255u) == 0u) { if (xb_ld(&(bar)[XB_TMO])) break; if (_sp > XB_SPIN_CAP) { atomicAdd(&(bar)[XB_TMO], 1u); break; } } } } while (0)

struct XcdBarrier {
    unsigned* bar; unsigned x;
    volatile LAS unsigned* st;
};

__device__ __forceinline__ XcdBarrier xcd_barrier_post(unsigned* bar, volatile LAS unsigned* st) {
    XcdBarrier b; b.bar = bar; b.x = xb_xcc_id(); b.st = st;
    if (threadIdx.x == 0) (void)xb_add(&bar[XB_XCNT(b.x)], 1u);
    return b;
}
__device__ __forceinline__ void xcd_barrier_complete(unsigned* bar, unsigned x, unsigned& nloc, unsigned& nx) {
    const unsigned G = gridDim.x * gridDim.y * gridDim.z;
    unsigned sum, cnt, mine, sp = 0u;
    for (;;) {
        sum = 0u; cnt = 0u; mine = 0u;
#pragma unroll
        for (unsigned j = 0; j < 16; ++j) { const unsigned c = xb_ld(&bar[XB_XCNT(j)]); sum += c; cnt += (c > 0u) ? 1u : 0u; mine = (j == x) ? c : mine; }
        if (sum == G) break;
        __builtin_amdgcn_s_sleep(1);
        if ((++sp & 255u) == 0u) { if (xb_ld(&bar[XB_TMO])) break; if (sp > XB_SPIN_CAP) { atomicAdd(&bar[XB_TMO], 1u); break; } }
    }
    nloc = mine > 0u ? mine : 1u; nx = cnt > 0u ? cnt : 1u;
}

__device__ __forceinline__ void xcd_barrier(const XcdBarrier& b) {
    asm volatile("s_waitcnt vmcnt(0)" ::: "memory");
    __syncthreads();
    if (threadIdx.x == 0) {
        unsigned* bar = b.bar;
        __builtin_amdgcn_s_waitcnt(0);
        unsigned nloc = b.st[0], nx = b.st[1];
        if (nloc == 0u) { xcd_barrier_complete(bar, b.x, nloc, nx); b.st[0] = nloc; b.st[1] = nx; }
        const unsigned old = xb_add(&bar[XB_XSUB(b.x)], 1u);
        const unsigned gen = old / nloc;
        if (old + 1u == (gen + 1u) * nloc) {
            __builtin_amdgcn_fence(__ATOMIC_RELEASE, "agent");
            asm volatile("s_waitcnt vmcnt(0)" ::: "memory");
            const unsigned og = xb_add(&bar[XB_TOP], 1u);
            const unsigned tg = og / nx;
            if (og + 1u == (tg + 1u) * nx) xb_add(&bar[XB_TOPGEN], 1u);
            else XB_SPIN(xb_ld(&bar[XB_TOPGEN]) == tg, bar);
            __builtin_amdgcn_fence(__ATOMIC_ACQUIRE, "agent");
            xb_add(&bar[XB_XGEN(b.x)], 1u);
            asm volatile("s_waitcnt vmcnt(0)" ::: "memory");
        } else {
            XB_SPIN(xb_ld(&bar[XB_XGEN(b.x)]) == gen, bar);
            __builtin_amdgcn_fence(__ATOMIC_ACQUIRE, "agent");
            asm volatile("s_waitcnt vmcnt(0)" ::: "memory");
        }
    }
    __syncthreads();
}

struct Args { const float* in[13]; float* out; unsigned char* ws; int ph_lo, ph_hi; };
static_assert(sizeof(Args) == 128, "Args has no padding");

__global__ void __launch_bounds__(NWAVES * 64, 2) mk_fwd(Args args) {
    extern __shared__ __attribute__((aligned(16))) unsigned char lds_raw[];
    Ctx C; C.lds = (LAS unsigned char*)lds_raw; C.tid = threadIdx.x; C.lane = C.tid & 63; C.wave = __builtin_amdgcn_readfirstlane(C.tid >> 6);
    C.gw = blockIdx.x * NWAVES + C.wave; C.NGW = gridDim.x * NWAVES;
    const int G = gridDim.x, bx = blockIdx.x;
    unsigned char* ws = args.ws;
    const float* x = args.in[0]; const float* cvec = args.in[1]; const float* w_ada = args.in[2]; const float* b_ada = args.in[3];
    const float* w1_gu = args.in[4]; const float* w1_down = args.in[5]; const float* w_in = args.in[6]; const float* qnw = args.in[7]; const float* knw = args.in[8];
    const float* conv_w = args.in[9]; const float* w_out = args.in[10]; const float* w2_gu = args.in[11]; const float* w2_down = args.in[12];
    float* mod = (float*)(ws + WS_MOD);
    bf16_t* W1GU = (bf16_t*)(ws + WS_W1GU); bf16_t* W1D = (bf16_t*)(ws + WS_W1D); bf16_t* WIN = (bf16_t*)(ws + WS_WIN); bf16_t* WOUT = (bf16_t*)(ws + WS_WOUT);
    bf16_t* W2GU = (bf16_t*)(ws + WS_W2GU); bf16_t* W2D = (bf16_t*)(ws + WS_W2D);
    bf16_t* H = (bf16_t*)(ws + WS_H); bf16_t* BIG = (bf16_t*)(ws + WS_BIG); float* X1 = (float*)(ws + WS_X1); bf16_t* AI = (bf16_t*)(ws + WS_AI);
    bf16_t* Qn = (bf16_t*)(ws + WS_QN); bf16_t* Kn = (bf16_t*)(ws + WS_KN); bf16_t* Vt = (bf16_t*)(ws + WS_VT);
    float* out = args.out;
    const int lo = args.ph_lo, hi = args.ph_hi;
    if (C.tid < 64) ((LAS unsigned*)(C.lds + LDSCTL_OFF))[C.tid] = 0u;
    __syncthreads();
    if (args.ph_hi > N_PHASES) cg::this_grid().sync();
    XcdBarrier bar = xcd_barrier_post((unsigned*)(ws + WS_CTL), (volatile LAS unsigned*)(C.lds + LDSCTL_OFF + 32));
#ifndef PROBE_REP
#define PROBE_REP -1
#endif
#ifndef PROBE_MASK
#define PROBE_MASK 0
#endif
#define NREP(k) (((k) == PROBE_REP || ((PROBE_MASK >> (k)) & 1)) ? 2 : 1)
#define IN(k) (lo <= (k) && (k) < hi)
#define SEAM(k) do { if (IN(k) && IN((k) + 1)) { xcd_barrier(bar); } } while (0)

    constexpr int I_GU = (D / 64) * (2 * FF / 64), I_DN = (FF / 64) * (D / 64), I_IN = (D / 64) * (NIN / 64), I_OUT = (D / 64) * (D / 64);
#define TR_REST_ITEM(r_) do { int r = (r_); \
        if (r < I_DN) { tr_weight_item(w1_down, FF, D, W1D, false, r, T, C.lane); break; } r -= I_DN; \
        if (r < I_IN) { tr_weight_item(w_in, D, NIN, WIN, false, r, T, C.lane); break; } r -= I_IN; \
        if (r < I_OUT) { tr_weight_item(w_out, D, D, WOUT, false, r, T, C.lane); break; } r -= I_OUT; \
        if (r < I_GU) { tr_weight_item(w2_gu, D, 2 * FF, W2GU, true, r, T, C.lane); break; } r -= I_GU; \
        tr_weight_item(w2_down, FF, D, W2D, false, r, T, C.lane); } while (0)
    constexpr int I_REST = 2 * I_DN + I_IN + I_OUT + I_GU;
    if (IN(0)) {
        LAS unsigned* T = (LAS unsigned*)(C.lds + C.wave * 16384);
        constexpr int I_ADA = (D / 32) * (NMOD * D / 256);
        for (int it = C.gw; it < I_ADA + I_GU; it += C.NGW) {
            if (it < I_ADA) adaln_item(cvec, w_ada, b_ada, mod, it, C.lane);
            else tr_weight_item(w1_gu, D, 2 * FF, W1GU, true, it - I_ADA, T, C.lane);
        }
        if (!IN(2)) for (int it = C.gw; it < I_REST; it += C.NGW) TR_REST_ITEM(it);
    }
    SEAM(0);
    if (IN(1)) for (int rep = 0; rep < NREP(1); ++rep) norm_phase(C, x, mod, 0, H);
    SEAM(1);
#ifdef PROBE_SYNC
    for (int q_ = 0; q_ < PROBE_SYNC; ++q_) xcd_barrier(bar);
#endif
    if (IN(2)) { pg8::Gemm g{H, W1GU, M, 2 * FF, D}; pg8::StaticOrder S; S.init(M, 2 * FF, G, bx); pg8::EpiSwiglu E{BIG, FF};
        pg8::gemm_phase<pg8::EpiSwiglu, pg8::StaticOrder, true, true>(C.lds, g, S, E);
        const int nun = (M / 256) * (2 * FF / 256), rounds = (nun + G - 1) / G, nshort = rounds * G - nun, first_short = G - nshort;
        if (IN(0)) { if (nshort > 0) { if (bx >= first_short) { LAS unsigned* T = (LAS unsigned*)(C.lds + C.wave * 16384);
                    for (int it = (bx - first_short) * NWAVES + C.wave; it < I_REST; it += nshort * NWAVES) TR_REST_ITEM(it); } }
            else { LAS unsigned* T = (LAS unsigned*)(C.lds + C.wave * 16384); for (int it = C.gw; it < I_REST; it += C.NGW) TR_REST_ITEM(it); } } }
    SEAM(2);
    if (IN(3)) _Pragma("unroll") for (int rep = 0; rep < NREP(3); ++rep) { pg8::Gemm g{BIG, W1D, M, D, FF}; pg8::StaticOrder S; S.init(M, D, G, bx); pg8::EpiResid E{x, X1, mod + 2 * D, 0.5f};
        pg8::gemm_phase<pg8::EpiResid, pg8::StaticOrder, true, true>(C.lds, g, S, E); }
    SEAM(3);
    if (IN(4)) norm_phase(C, X1, mod, 1, H);
    SEAM(4);
    if (IN(5)) _Pragma("unroll") for (int rep = 0; rep < NREP(5); ++rep) { pg8::Gemm g{H, WIN, M, NIN, D}; pg8::StaticOrder S; S.init(M, NIN, G, bx); pg8::EpiStore E{BIG, NIN};
        pg8::gemm_phase<pg8::EpiStore, pg8::StaticOrder, true, true>(C.lds, g, S, E); }
    SEAM(5);
    if (IN(6)) for (int rep = 0; rep < NREP(6); ++rep) prepass_phase(C, BIG, qnw, knw, conv_w, Qn, Kn, Vt, AI);
    SEAM(6);
    if (IN(7)) for (int rep = 0; rep < NREP(7); ++rep) { for (int u = bx; u < BATCH * NHEAD * (SEQ / 256); u += G) { const int uu = BATCH * NHEAD * (SEQ / 256) - 1 - u; attn_unit(C, uu % (BATCH * NHEAD), uu / (BATCH * NHEAD), Qn, Kn, Vt, AI); } }
    SEAM(7);
    if (IN(8)) _Pragma("unroll") for (int rep = 0; rep < NREP(8); ++rep) { pg8::Gemm g{AI, WOUT, M, D, D}; pg8::StaticOrder S; S.init(M, D, G, bx); pg8::EpiResid E{X1, out, mod + 5 * D, 1.0f};
        pg8::gemm_phase<pg8::EpiResid, pg8::StaticOrder, true, true>(C.lds, g, S, E); }
    SEAM(8);
    if (IN(9)) norm_phase(C, out, mod, 2, H);
    SEAM(9);
    if (IN(10)) { pg8::Gemm g{H, W2GU, M, 2 * FF, D}; pg8::StaticOrder S; S.init(M, 2 * FF, G, bx); pg8::EpiSwiglu E{BIG, FF};
        pg8::gemm_phase<pg8::EpiSwiglu, pg8::StaticOrder, true, true>(C.lds, g, S, E); }
    SEAM(10);
    if (IN(11)) { pg8::Gemm g{BIG, W2D, M, D, FF}; pg8::StaticOrder S; S.init(M, D, G, bx); pg8::EpiResid E{out, out, mod + 8 * D, 0.5f};
        pg8::gemm_phase<pg8::EpiResid, pg8::StaticOrder, true, true>(C.lds, g, S, E); }
#undef IN
#undef SEAM
}

extern "C" void kernel_launch(void* const* d_in, const int* in_sizes, int n_in, void* d_out, int out_size, void* d_ws, size_t ws_size, hipStream_t stream) {
    static int grid = 0;
    if (grid == 0) {
        if (n_in != 13 || in_sizes[0] != M * D || out_size != M * D || ws_size < WS_END) { fprintf(stderr, "kernel_launch: unexpected shapes (n_in %d, in0 %d, out %d, ws %zu)\n", n_in, n_in > 0 ? in_sizes[0] : -1, out_size, ws_size); grid = -1; return; }
        int dev = 0, cus = 0, per_cu = 0;
        if (hipGetDevice(&dev) != hipSuccess || hipDeviceGetAttribute(&cus, hipDeviceAttributeMultiprocessorCount, dev) != hipSuccess) { grid = -1; return; }
        if (hipFuncSetAttribute((const void*)mk_fwd, hipFuncAttributeMaxDynamicSharedMemorySize, LDS_BYTES) != hipSuccess) { fprintf(stderr, "kernel_launch: hipFuncSetAttribute failed\n"); grid = -1; return; }
        if (hipOccupancyMaxActiveBlocksPerMultiprocessor(&per_cu, (const void*)mk_fwd, NWAVES * 64, LDS_BYTES) != hipSuccess || per_cu < 1) { fprintf(stderr, "kernel_launch: occupancy query says %d\n", per_cu); per_cu = 1; }
        (void)hipGetLastError();
        grid = cus * per_cu;
    }
    if (grid < 0) return;
    (void)hipMemsetAsync((char*)d_ws + WS_MOD, 0, CTL_ZERO_BYTES, stream);
    Args a{};
    for (int i = 0; i < 13; ++i) a.in[i] = (const float*)d_in[i];
    a.out = (float*)d_out; a.ws = (unsigned char*)d_ws;
#if MK_COOP
    a.ph_lo = 0; a.ph_hi = N_PHASES;
    void* kargs[] = {&a};
    hipError_t e = hipLaunchCooperativeKernel((const void*)mk_fwd, dim3(grid), dim3(NWAVES * 64), kargs, LDS_BYTES, stream);
    if (e != hipSuccess) fprintf(stderr, "cooperative launch failed: %s (grid %d)\n", hipGetErrorString(e), grid);
#else
    for (int p = 0; p < N_PHASES; ++p) { a.ph_lo = p; a.ph_hi = p + 1; hipLaunchKernelGGL(mk_fwd, dim3(grid), dim3(NWAVES * 64), LDS_BYTES, stream, a); }
#endif
}
```
